# Optimizing an MI355X kernel written in HIP

```python
import math
import jax
import jax.numpy as jnp
from jax import lax
import numpy as np

D_MODEL = 1024
BATCH = 16
SEQ = 256
DEPTH = 2
DEC_BATCH = 2
DEC_SEQ = 4096
PAST_LEN = 256

GRID_W = 64
N_BRANCH = 3
NA_HEADS = 8
NA_HEAD_DIM = 64
NA_WIDTH = NA_HEADS * NA_HEAD_DIM
NA_WIN_ROWS = 8
NA_WIN_COLS = 16
FNET_GROUPS = 4
FNET_GROUP_DIM = 128
FNET_WIDTH = FNET_GROUPS * FNET_GROUP_DIM
DIFF_HEADS = 4
DIFF_QK_DIM = 64
DIFF_V_DIM = 2 * DIFF_QK_DIM
DIFF_WIDTH = DIFF_HEADS * DIFF_V_DIM
BRANCH_WIDTH = 512
IN_WIDTH = 4 * NA_WIDTH + 2 * FNET_WIDTH + 4 * DIFF_WIDTH + N_BRANCH * D_MODEL
ROPE_BASE = 10000.0
EPS = 1e-6
Q_BLOCK = 128
NEG_INF = -1e30

kernel_name = "hybrid_diffusion_na_fnet_diffattn_step"

F32 = jnp.float32


def rmsnorm(x, g):
    xf = x.astype(F32)
    y = xf * lax.rsqrt(jnp.mean(xf * xf, axis=-1, keepdims=True) + EPS)
    return (y * g.astype(F32)).astype(x.dtype)


def adaln(cvec, w_mod, b_mod):
    mod = jax.nn.silu(cvec) @ w_mod + b_mod
    mod = mod.reshape(-1, 1, 3 * D_MODEL)
    return jnp.split(mod, 3, axis=-1)


def split_projection(p):
    sizes = [NA_WIDTH] * 4 + [FNET_WIDTH] * 2 + [DIFF_WIDTH] * 4 + [N_BRANCH * D_MODEL]
    offs = [int(o) for o in np.cumsum(sizes)[:-1]]
    return jnp.split(p, offs, axis=-1)


def to_heads(x, n_heads):
    B, T, _ = x.shape
    return x.reshape(B, T, n_heads, -1).transpose(0, 2, 1, 3)


def from_heads(x):
    B, H, T, d = x.shape
    return x.transpose(0, 2, 1, 3).reshape(B, T, H * d)


def diff_qk_heads(x):
    B, T, _ = x.shape
    return x.reshape(B, T, DIFF_HEADS, 2, DIFF_QK_DIM).transpose(0, 2, 1, 3, 4)


def axial_rope_tables(T, dtype):
    t = jnp.arange(T)
    row = (t // GRID_W).astype(F32)
    col = (t % GRID_W).astype(F32)
    half = DIFF_QK_DIM // 2
    inv = ROPE_BASE ** (-jnp.arange(0, half, 2, dtype=F32) / half)
    ang_r = row[:, None] * inv
    ang_c = col[:, None] * inv
    return tuple(a.astype(dtype) for a in (jnp.cos(ang_r), jnp.sin(ang_r), jnp.cos(ang_c), jnp.sin(ang_c)))


def rope_1d(x, cos, sin):
    x1, x2 = jnp.split(x, 2, axis=-1)
    return jnp.concatenate([x1 * cos - x2 * sin, x2 * cos + x1 * sin], axis=-1)


def apply_axial_rope(x, tables):
    cr, sr, cc, sc = (a[:, None, :] for a in tables)
    xr, xc = jnp.split(x, 2, axis=-1)
    return jnp.concatenate([rope_1d(xr, cr, sr), rope_1d(xc, cc, sc)], axis=-1)


def map_query_blocks(fn, q):
    B, H, T = q.shape[:3]
    nb = T // Q_BLOCK
    qb = jnp.moveaxis(q.reshape(B, H, nb, Q_BLOCK, *q.shape[3:]), 2, 0)
    o = lax.map(fn, qb)
    o = jnp.moveaxis(o, 0, 2)
    return o.reshape(B, H, T, o.shape[-1])


def softmax_attention(q, k, v):
    scale = q.shape[-1] ** -0.5

    def block(qb):
        s = jnp.einsum('bhqd,bhkd->bhqk', qb, k).astype(F32) * scale
        p = jax.nn.softmax(s, axis=-1).astype(v.dtype)
        return jnp.einsum('bhqk,bhkd->bhqd', p, v)

    return map_query_blocks(block, q)


def neighbourhood_attention(q, k, v, k_ctx, v_ctx, rpb):
    B, H, T, dh = q.shape
    rows = T // GRID_W
    wr = min(NA_WIN_ROWS, rows)
    wc = NA_WIN_COLS
    scale = dh ** -0.5
    r = jnp.arange(rows)
    row_start = jnp.clip(r - wr // 2, 0, rows - wr)
    key_rows = row_start[:, None] + jnp.arange(wr)[None, :]
    c = jnp.arange(GRID_W)
    col_start = jnp.clip(c - wc // 2, 0, GRID_W - wc)
    col_ok = (c[None, :] >= col_start[:, None]) & (c[None, :] < col_start[:, None] + wc)
    dr_idx = key_rows - r[:, None] + NA_WIN_ROWS - 1
    dc_idx = jnp.clip(c[None, :] - c[:, None] + wc - 1, 0, 2 * wc - 2)
    bias = rpb[:, dr_idx[:, None, :, None], dc_idx[None, :, None, :]].astype(F32)

    qg = q.reshape(B, H, rows, GRID_W, dh)
    kg = k.reshape(B, H, rows, GRID_W, dh)[:, :, key_rows]
    vg = v.reshape(B, H, rows, GRID_W, dh)[:, :, key_rows]
    s_loc = jnp.einsum('bhrqd,bhriwd->bhrqiw', qg, kg).astype(F32) * scale + bias[None]
    s_loc = jnp.where(col_ok[None, None, None, :, None, :], s_loc, NEG_INF)
    s_loc = s_loc.reshape(B, H, rows, GRID_W, wr * GRID_W)
    s_ctx = jnp.einsum('bhrqd,bhnd->bhrqn', qg, k_ctx).astype(F32) * scale
    p = jax.nn.softmax(jnp.concatenate([s_loc, s_ctx], axis=-1), axis=-1).astype(v.dtype)
    p_loc = p[..., :wr * GRID_W].reshape(B, H, rows, GRID_W, wr, GRID_W)
    p_ctx = p[..., wr * GRID_W:]
    o = jnp.einsum('bhrqiw,bhriwd->bhrqd', p_loc, vg) + jnp.einsum('bhrqn,bhnd->bhrqd', p_ctx, v_ctx)
    return o.reshape(B, H, T, dh)


def diff_lambda(lq1, lk1, lq2, lk2, lam_init):
    return (jnp.exp(jnp.sum(lq1.astype(F32) * lk1.astype(F32)))
            - jnp.exp(jnp.sum(lq2.astype(F32) * lk2.astype(F32))) + lam_init)


def diff_attention(q, k, v, lam, subln_g, lam_init):
    scale = DIFF_QK_DIM ** -0.5

    def block(qb):
        s = jnp.einsum('bhqmd,bhkmd->bhmqk', qb, k).astype(F32) * scale
        p = jax.nn.softmax(s, axis=-1)
        a = (p[:, :, 0] - lam * p[:, :, 1]).astype(v.dtype)
        return jnp.einsum('bhqk,bhkd->bhqd', a, v)

    o = map_query_blocks(block, q)
    return rmsnorm(o, subln_g) * (1.0 - lam_init)


def fourier_mix(u, w_f):
    B, T, _ = u.shape
    ug = u.astype(F32).reshape(B, T, FNET_GROUPS, FNET_GROUP_DIM)
    f = jnp.fft.fftn(ug, axes=(1, 3), norm="ortho").real.astype(u.dtype).reshape(B, T, FNET_WIDTH)
    return f @ w_f


def merge_branches(gate_logits, outs, zs, w_branch_l, w_out_l):
    g = jax.nn.sigmoid(gate_logits)
    y = 0.0
    for b in range(N_BRANCH):
        gb = g[..., b * D_MODEL:(b + 1) * D_MODEL]
        y = y + gb * ((outs[b] * jax.nn.silu(zs[b])) @ w_branch_l[b])
    return y @ w_out_l


def mixer_input(x, cvec, norm_g, w_mod, b_mod, w_in):
    shift, scale, gate = adaln(cvec, w_mod, b_mod)
    h = rmsnorm(x, norm_g) * (1.0 + scale) + shift
    return gate, split_projection(h @ w_in)


def setup_inputs(seed: int = 0) -> dict:
    key = jax.random.key(seed)
    ks = jax.random.split(key, 24)
    n = jax.random.normal
    D = D_MODEL
    return {
        "x_prompt": n(ks[0], (BATCH, SEQ, D), F32),
        "x_sample": n(ks[1], (DEC_BATCH, DEC_SEQ, D), F32),
        "cache_na_k": n(ks[2], (DEC_BATCH, DEPTH, NA_HEADS, PAST_LEN, NA_HEAD_DIM), F32),
        "cache_na_v": n(ks[3], (DEC_BATCH, DEPTH, NA_HEADS, PAST_LEN, NA_HEAD_DIM), F32),
        "cache_diff_k": n(ks[4], (DEC_BATCH, DEPTH, DIFF_HEADS, PAST_LEN, 2 * DIFF_QK_DIM), F32),
        "cache_diff_v": n(ks[5], (DEC_BATCH, DEPTH, DIFF_HEADS, PAST_LEN, DIFF_V_DIM), F32),
        "c": n(ks[6], (DEC_BATCH, D), F32),
        "c_ctx": n(ks[7], (D,), F32),
        "norm_g": 1.0 + 0.02 * n(ks[8], (DEPTH, D), F32),
        "w_mod": 0.5 * D ** -0.5 * n(ks[9], (DEPTH, D, 3 * D), F32),
        "b_mod": 0.01 * n(ks[10], (DEPTH, 3 * D), F32),
        "w_in": D ** -0.5 * n(ks[11], (DEPTH, D, IN_WIDTH), F32),
        "na_rpb": 0.1 * n(ks[12], (DEPTH, NA_HEADS, 2 * NA_WIN_ROWS - 1, 2 * NA_WIN_COLS - 1), F32),
        "fnet_w": FNET_WIDTH ** -0.5 * n(ks[13], (DEPTH, FNET_WIDTH, FNET_WIDTH), F32),
        "diff_lq1": 0.1 * n(ks[14], (DEPTH, DIFF_QK_DIM), F32),
        "diff_lk1": 0.1 * n(ks[15], (DEPTH, DIFF_QK_DIM), F32),
        "diff_lq2": 0.1 * n(ks[16], (DEPTH, DIFF_QK_DIM), F32),
        "diff_lk2": 0.1 * n(ks[17], (DEPTH, DIFF_QK_DIM), F32),
        "diff_subln_g": 1.0 + 0.02 * n(ks[18], (DEPTH, DIFF_V_DIM), F32),
        "w_branch": BRANCH_WIDTH ** -0.5 * n(ks[19], (DEPTH, N_BRANCH, BRANCH_WIDTH, D), F32),
        "w_out": D ** -0.5 * n(ks[20], (DEPTH, D, D), F32),
        "final_g": 1.0 + 0.02 * n(ks[21], (D,), F32),
    }


def reference(x_prompt, x_sample, cache_na_k, cache_na_v, cache_diff_k, cache_diff_v, c, c_ctx,
              norm_g, w_mod, b_mod, w_in, na_rpb, fnet_w, diff_lq1, diff_lk1, diff_lq2, diff_lk2,
              diff_subln_g, w_branch, w_out, final_g):
    xp = x_prompt
    Bp, N = xp.shape[0], xp.shape[1]
    na_ks, na_vs, d_ks, d_vs = [], [], [], []
    for l in range(DEPTH):
        lam_init = 0.8 - 0.6 * math.exp(-0.3 * l)
        lam = diff_lambda(diff_lq1[l], diff_lk1[l], diff_lq2[l], diff_lk2[l], lam_init)
        gate, (na_q, na_k, na_v, na_z, f_u, f_z, d_q, d_k, d_v, d_z, g) = mixer_input(
            xp, c_ctx, norm_g[l], w_mod[l], b_mod[l], w_in[l])
        qa, ka, va = to_heads(na_q, NA_HEADS), to_heads(na_k, NA_HEADS), to_heads(na_v, NA_HEADS)
        o_na = from_heads(softmax_attention(qa, ka, va))
        o_f = fourier_mix(f_u, fnet_w[l])
        qd, kd, vd = diff_qk_heads(d_q), diff_qk_heads(d_k), to_heads(d_v, DIFF_HEADS)
        o_d = from_heads(diff_attention(qd, kd, vd, lam, diff_subln_g[l], lam_init))
        y = merge_branches(g, (o_na, o_f, o_d), (na_z, f_z, d_z), w_branch[l], w_out[l])
        xp = xp + gate * y
        na_ks.append(ka)
        na_vs.append(va)
        d_ks.append(kd.reshape(Bp, DIFF_HEADS, N, 2 * DIFF_QK_DIM))
        d_vs.append(vd)
    y_prompt = rmsnorm(xp, final_g)
    new_na_k = jnp.stack(na_ks, axis=1)
    new_na_v = jnp.stack(na_vs, axis=1)
    new_diff_k = jnp.stack(d_ks, axis=1)
    new_diff_v = jnp.stack(d_vs, axis=1)

    xs = x_sample
    Bs, T = xs.shape[0], xs.shape[1]
    Nc = cache_diff_k.shape[3]
    tables = axial_rope_tables(T, xs.dtype)
    for l in range(DEPTH):
        lam_init = 0.8 - 0.6 * math.exp(-0.3 * l)
        lam = diff_lambda(diff_lq1[l], diff_lk1[l], diff_lq2[l], diff_lk2[l], lam_init)
        gate, (na_q, na_k, na_v, na_z, f_u, f_z, d_q, d_k, d_v, d_z, g) = mixer_input(
            xs, c, norm_g[l], w_mod[l], b_mod[l], w_in[l])
        qa, ka, va = to_heads(na_q, NA_HEADS), to_heads(na_k, NA_HEADS), to_heads(na_v, NA_HEADS)
        o_na = from_heads(neighbourhood_attention(qa, ka, va, cache_na_k[:, l], cache_na_v[:, l], na_rpb[l]))
        o_f = fourier_mix(f_u, fnet_w[l])
        qd = apply_axial_rope(diff_qk_heads(d_q), tables)
        kd = apply_axial_rope(diff_qk_heads(d_k), tables)
        vd = to_heads(d_v, DIFF_HEADS)
        k_ctx = cache_diff_k[:, l].reshape(Bs, DIFF_HEADS, Nc, 2, DIFF_QK_DIM)
        k_all = jnp.concatenate([kd, k_ctx], axis=2)
        v_all = jnp.concatenate([vd, cache_diff_v[:, l]], axis=2)
        o_d = from_heads(diff_attention(qd, k_all, v_all, lam, diff_subln_g[l], lam_init))
        y = merge_branches(g, (o_na, o_f, o_d), (na_z, f_z, d_z), w_branch[l], w_out[l])
        xs = xs + gate * y
    y_sample = rmsnorm(xs, final_g)
    return (y_prompt, y_sample, new_na_k, new_na_v, new_diff_k, new_diff_v)
```

```cpp
#include <hip/hip_runtime.h>
#include <hip/hip_cooperative_groups.h>
#include <cstdio>
namespace cg = cooperative_groups;

typedef unsigned short u16;
using bf16x8 = __attribute__((ext_vector_type(8))) short;
using s16x4  = __attribute__((ext_vector_type(4))) short;
using f32x16 = __attribute__((ext_vector_type(16))) float;
typedef __attribute__((ext_vector_type(2))) float f32x2_t;
typedef __attribute__((ext_vector_type(2))) __bf16 bf16x2_t;

#define DI __device__ __forceinline__
#define MFMA32(a, b, c) __builtin_amdgcn_mfma_f32_32x32x16_bf16((a), (b), (c), 0, 0, 0)

struct Params {
  const float *x_prompt, *x_sample, *cna_k, *cna_v, *cdk, *cdv, *c, *c_ctx, *norm_g, *w_mod, *b_mod, *w_in, *na_rpb, *fnet_w,
      *lq1, *lk1, *lq2, *lk2, *subln_g, *w_branch, *w_out, *final_g;
  float* out;
  char* ws;
};

constexpr size_t SEGE = 12288ull * 512ull;
constexpr size_t SEGB = SEGE * 2;
constexpr size_t OFF_P = 0;
constexpr size_t OFF_WT = OFF_P + 11 * SEGB;
constexpr size_t WT_L = 8704ull * 1024ull;
constexpr size_t OFF_WB = OFF_WT + 2 * WT_L * 2;
constexpr size_t OFF_WO = OFF_WB + 2ull * 3 * 1024 * 512 * 2;
constexpr size_t OFF_WF = OFF_WO + 2ull * 1024 * 1024 * 2;
constexpr size_t OFF_H = OFF_WF + 2ull * 512 * 512 * 2;
constexpr size_t OFF_F = OFF_H + 12288ull * 1024 * 2;
constexpr size_t OFF_AT = OFF_F + SEGB;
constexpr size_t OFF_CNK = OFF_AT + 2ull * 2 * 512 * 4096 * 2;
constexpr size_t OFF_CNVT = OFF_CNK + 524288ull * 2;
constexpr size_t OFF_CDK = OFF_CNVT + 524288ull * 2;
constexpr size_t OFF_CDVT = OFF_CDK + 524288ull * 2;
constexpr size_t OFF_D1 = OFF_CDVT + 524288ull * 2;
constexpr size_t OFF_D2 = OFF_D1 + 128 * 128 * 2;
constexpr size_t OFF_D256 = OFF_D2 + 64 * 128 * 2;
constexpr size_t OFF_TW = OFF_D256 + 256 * 512 * 2;
constexpr size_t OFF_ROPE = OFF_TW + 4096 * 8;
constexpr size_t OFF_MOD = OFF_ROPE + 1024 * 8;
constexpr size_t OFF_LAM = OFF_MOD + 2 * 3 * 3072 * 4;
constexpr size_t OFF_BAR = OFF_LAM + 256;
constexpr size_t BAR_BYTES = 3456 * 4;
constexpr size_t WS_END = OFF_BAR + BAR_BYTES;
static_assert(WS_END <= 268435456ull, "workspace too large");

constexpr int CTX_T = 2097152;
constexpr float QSCALE = 0.125f * 1.44269504088896f;
constexpr float LOG2E = 1.44269504088896f;

constexpr size_t OUT_NAK = 12582912, OUT_NAV = 16777216, OUT_DK = 20971520, OUT_DV = 25165824;

DI unsigned pk2(float a, float b) {
  bf16x2_t q = __builtin_convertvector((f32x2_t){a, b}, bf16x2_t);
  return __builtin_bit_cast(unsigned, q);
}
DI u16 f2bf(float a) { return (u16)(pk2(a, 0.f) & 0xffffu); }
DI float bf2f(unsigned v) { return __uint_as_float(v << 16); }
DI int crow(int i, int hh) { return (i & 3) + 8 * (i >> 2) + 4 * hh; }
DI float silu_f(float x) { return x / (1.f + __expf(-x)); }
DI float sigmoid_f(float x) { return 1.f / (1.f + __expf(-x)); }
DI float ex2(float x) { return __builtin_amdgcn_exp2f(x); }
DI float fmax_nc(float a, float b) { return __builtin_amdgcn_fmed3f(a, b, __builtin_inff()); }

DI u16* Pseg(const Params& p, int s) { return (u16*)(p.ws + OFF_P) + (size_t)s * SEGE; }
DI u16* WTl(const Params& p, int l) { return (u16*)(p.ws + OFF_WT) + (size_t)l * WT_L; }
DI const float* xin(const Params& p, int l, int tok) {
  if (l == 0) return tok < 4096 ? p.x_prompt + (size_t)tok * 1024 : p.x_sample + (size_t)(tok - 4096) * 1024;
  return p.out + (size_t)tok * 1024;
}
DI int vec_of(int tok) { return tok < 4096 ? 0 : 1 + ((tok - 4096) >> 12); }

DI void zero16(f32x16& a) {
#pragma unroll
  for (int i = 0; i < 16; ++i) a[i] = 0.f;
}
DI bf16x8 pack8(const f32x16& x, int s) {
  unsigned a = pk2(x[8 * s], x[8 * s + 1]), b = pk2(x[8 * s + 2], x[8 * s + 3]), c = pk2(x[8 * s + 4], x[8 * s + 5]),
           d = pk2(x[8 * s + 6], x[8 * s + 7]);
  uint4 u = make_uint4(a, b, c, d);
  return __builtin_bit_cast(bf16x8, u);
}

DI void store_pair16(u16* p_g  , uint2 a, uint2 b, int hh) {
  const auto r0 = __builtin_amdgcn_permlane32_swap(a.x, b.x, false, false);
  const auto r1 = __builtin_amdgcn_permlane32_swap(a.y, b.y, false, false);
  *(uint4*)(p_g + 8 * hh) = make_uint4(r0[0], r1[0], r0[1], r1[1]);
}

DI void load_pair16(const u16* p_g  , int hh, uint2& a, uint2& b) {
  const uint4 L = *(const uint4*)(p_g + 8 * hh);
  const auto r0 = __builtin_amdgcn_permlane32_swap(L.x, L.z, false, false);
  const auto r1 = __builtin_amdgcn_permlane32_swap(L.y, L.w, false, false);
  a = make_uint2(r0[0], r1[0]);
  b = make_uint2(r0[1], r1[1]);
}

constexpr int LDT = 72;
template <int NI>
DI void g_compute(const u16* Ac, const u16* Bc, f32x16 (&acc)[2][NI]) {
#pragma unroll
  for (int s = 0; s < 4; ++s) {
    const bf16x8 a0 = *(const bf16x8*)(Ac + s * 16);
    const bf16x8 a1 = *(const bf16x8*)(Ac + 32 * LDT + s * 16);
    bf16x8 b[NI];
#pragma unroll
    for (int ni = 0; ni < NI; ++ni) b[ni] = *(const bf16x8*)(Bc + ni * 32 * LDT + s * 16);
#pragma unroll
    for (int ni = 0; ni < NI; ++ni) {
      acc[0][ni] = MFMA32(a0, b[ni], acc[0][ni]);
      acc[1][ni] = MFMA32(a1, b[ni], acc[1][ni]);
    }
  }
}
template <int NI, bool PF2 = true, class FA, class FB>
DI void gemm_core(FA arow, FB brow, int K, f32x16 (&acc)[2][NI], u16* smem) {
  u16* As = smem;
  u16* Bs = smem + 2 * 128 * LDT;
  const int tid = threadIdx.x, lane = tid & 63, wid = tid >> 6, wr = wid >> 1, wc = wid & 1;
  const int lrow = tid >> 3, lchk = (tid & 7) * 8;
  const int cl = lane & 31, hh = lane >> 5;
  const u16* pa0 = arow(lrow) + lchk;
  const u16* pa1 = arow(lrow + 32) + lchk;
  const u16* pa2 = arow(lrow + 64) + lchk;
  const u16* pa3 = arow(lrow + 96) + lchk;
  const u16* pb0 = brow(lrow) + lchk;
  const u16* pb1 = brow(lrow + 32) + lchk;
  const u16* pb2 = NI == 2 ? brow(lrow + 64) + lchk : pb0;
  const u16* pb3 = NI == 2 ? brow(lrow + 96) + lchk : pb0;
  const int nk = K >> 6;
  const u16* Ac0 = As + (wr * 64 + cl) * LDT + hh * 8;
  const u16* Bc0 = Bs + (wc * 32 * NI + cl) * LDT + hh * 8;
  u16* Aw = As + lrow * LDT + lchk;
  u16* Bw = Bs + lrow * LDT + lchk;
  uint4 x0, x1, x2, x3, x4, x5, x6, x7;
  uint4 y0, y1, y2, y3, y4, y5, y6, y7;
#define GL(P, OFF) (*(const uint4*)((P) + (OFF)))
#define GLOAD0(OFF)                                                                   \
  x0 = GL(pa0, OFF); x1 = GL(pa1, OFF); x2 = GL(pa2, OFF); x3 = GL(pa3, OFF);          \
  x4 = GL(pb0, OFF); x5 = GL(pb1, OFF);                                                \
  if (NI == 2) { x6 = GL(pb2, OFF); x7 = GL(pb3, OFF); }
#define GLOAD1(OFF)                                                                   \
  y0 = GL(pa0, OFF); y1 = GL(pa1, OFF); y2 = GL(pa2, OFF); y3 = GL(pa3, OFF);          \
  y4 = GL(pb0, OFF); y5 = GL(pb1, OFF);                                                \
  if (NI == 2) { y6 = GL(pb2, OFF); y7 = GL(pb3, OFF); }
#define GS(P, V) (*(uint4*)(P) = (V))
#define GSTORE0(AB, BB)                                                               \
  GS((AB), x0); GS((AB) + 32 * LDT, x1); GS((AB) + 64 * LDT, x2); GS((AB) + 96 * LDT, x3); \
  GS((BB), x4); GS((BB) + 32 * LDT, x5);                                               \
  if (NI == 2) { GS((BB) + 64 * LDT, x6); GS((BB) + 96 * LDT, x7); }
#define GSTORE1(AB, BB)                                                               \
  GS((AB), y0); GS((AB) + 32 * LDT, y1); GS((AB) + 64 * LDT, y2); GS((AB) + 96 * LDT, y3); \
  GS((BB), y4); GS((BB) + 32 * LDT, y5);                                               \
  if (NI == 2) { GS((BB) + 64 * LDT, y6); GS((BB) + 96 * LDT, y7); }
  if (!PF2) {
    GLOAD0(0)
    GSTORE0(Aw, Bw)
    __syncthreads();
    for (int kt = 0; kt < nk; ++kt) {
      const int cur = kt & 1;
      const bool more = kt + 1 < nk;
      if (more) { GLOAD0((kt + 1) * 64) }
      g_compute<NI>(Ac0 + cur * 128 * LDT, Bc0 + cur * 64 * NI * LDT, acc);
      if (more) { GSTORE0(Aw + (cur ^ 1) * 128 * LDT, Bw + (cur ^ 1) * 64 * NI * LDT) }
      __syncthreads();
    }
    return;
  }
  GLOAD0(0)
  GSTORE0(Aw, Bw)
  GLOAD1(64)
  __syncthreads();
  for (int kt = 0; kt < nk; kt += 2) {
    const int k2 = (kt + 2) * 64;
    const bool m2 = kt + 2 < nk;
    if (m2) { GLOAD0(k2) }
    __builtin_amdgcn_sched_barrier(0);
    g_compute<NI>(Ac0, Bc0, acc);
    GSTORE1(Aw + 128 * LDT, Bw + 64 * NI * LDT)
    __syncthreads();
    if (m2) { GLOAD1(k2 + 64) }
    __builtin_amdgcn_sched_barrier(0);
    g_compute<NI>(Ac0 + 128 * LDT, Bc0 + 64 * NI * LDT, acc);
    if (m2) { GSTORE0(Aw, Bw) }
    __syncthreads();
  }
#undef GL
#undef GS
#undef GLOAD0
#undef GLOAD1
#undef GSTORE0
#undef GSTORE1
}

DI bool xcd_map(int it, int NF, int NT, int GXF, int& ft, int& tt) {
  const int x = blockIdx.x & 7, j = blockIdx.x >> 3, nb = gridDim.x >> 3;
  const int GXT = 8 / GXF, Fx = NF / GXF, Tx = NT / GXT;
  const int idx = j + it * nb;
  if (idx >= Fx * Tx) return false;
  ft = (x % GXF) * Fx + idx % Fx;
  tt = (x / GXF) * Tx + idx / Fx;
  return true;
}

DI void phase_prep(const Params& p, char* smem, int part) {
  const int tid = threadIdx.x;
  u16* WB = (u16*)(p.ws + OFF_WB);
  u16* WO = (u16*)(p.ws + OFF_WO);
  u16* WF = (u16*)(p.ws + OFF_WF);
  if (part & 2) {
    float* t = (float*)smem;
    for (int job = blockIdx.x; job < 5248; job += gridDim.x) {
      const float* src;
      u16* dst;
      int ldsrc, lddst, k0, ns0, nd0;
      int j = job;
      if (j < 3840) {
        const int l = j / 1920;
        j %= 1920;
        const int nt = j >> 4, kt = j & 15;
        const int nd = nt < 32 ? nt * 64 : 3072 + (nt - 32) * 64;
        const int nsrc = nt < 32 ? nd : nd - 512;
        src = p.w_in + (size_t)l * 1024 * 8192; ldsrc = 8192; dst = WTl(p, l); lddst = 1024; k0 = kt * 64; ns0 = nsrc; nd0 = nd;
      } else if (j < 4608) {
        j -= 3840;
        const int lb = j >> 7;
        j &= 127;
        const int nt = j >> 3, kt = j & 7;
        src = p.w_branch + (size_t)lb * 512 * 1024; ldsrc = 1024; dst = WB + (size_t)lb * 1024 * 512; lddst = 512; k0 = kt * 64; ns0 = nd0 = nt * 64;
      } else if (j < 5120) {
        j -= 4608;
        const int l = j >> 8;
        j &= 255;
        const int nt = j >> 4, kt = j & 15;
        src = p.w_out + (size_t)l * 1024 * 1024; ldsrc = 1024; dst = WO + (size_t)l * 1024 * 1024; lddst = 1024; k0 = kt * 64; ns0 = nd0 = nt * 64;
      } else {
        j -= 5120;
        const int l = j >> 6;
        j &= 63;
        const int nt = j >> 3, kt = j & 7;
        src = p.fnet_w + (size_t)l * 512 * 512; ldsrc = 512; dst = WF + (size_t)l * 512 * 512; lddst = 512; k0 = kt * 64; ns0 = nd0 = nt * 64;
      }
#pragma unroll
      for (int i = 0; i < 4; ++i) {
        const int row = (tid >> 4) + 16 * i, c4 = (tid & 15) * 4;
        const float4 v = *(const float4*)(src + (size_t)(k0 + row) * ldsrc + ns0 + c4);
        t[row * 65 + c4 + 0] = v.x; t[row * 65 + c4 + 1] = v.y; t[row * 65 + c4 + 2] = v.z; t[row * 65 + c4 + 3] = v.w;
      }
      __syncthreads();
#pragma unroll
      for (int i = 0; i < 2; ++i) {
        const int n = (tid >> 3) + 32 * i, kk = (tid & 7) * 8;
        uint4 o;
        o.x = pk2(t[(kk + 0) * 65 + n], t[(kk + 1) * 65 + n]);
        o.y = pk2(t[(kk + 2) * 65 + n], t[(kk + 3) * 65 + n]);
        o.z = pk2(t[(kk + 4) * 65 + n], t[(kk + 5) * 65 + n]);
        o.w = pk2(t[(kk + 6) * 65 + n], t[(kk + 7) * 65 + n]);
        *(uint4*)(dst + (size_t)(nd0 + n) * lddst + k0 + kk) = o;
      }
      __syncthreads();
    }
  }
  if (part & 2) {
    float* tt = (float*)smem;
    float* ctab = tt + 128 * 32;
    for (int job = blockIdx.x; job < 256; job += gridDim.x) {
      const int l = job >> 7, g = (job >> 5) & 3, k0 = (job & 31) * 32;
      if (tid < 128) ctab[tid] = cospif((float)tid * (1.f / 64.f));
#pragma unroll
      for (int i = 0; i < 4; ++i) {
        const int idx = tid + 256 * i, row = idx >> 5, c4 = (idx & 31) * 4;
        const float4 v = *(const float4*)(p.w_in + ((size_t)l * 1024 + k0 + row) * 8192 + 2048 + g * 128 + c4);
        tt[(c4 + 0) * 32 + row] = v.x; tt[(c4 + 1) * 32 + row] = v.y; tt[(c4 + 2) * 32 + row] = v.z; tt[(c4 + 3) * 32 + row] = v.w;
      }
      __syncthreads();
      const int m = tid & 127, cs = tid >> 7;
      float acc[32];
#pragma unroll
      for (int k = 0; k < 32; ++k) acc[k] = 0.f;
      for (int c = 0; c < 128; ++c) {
        const float tr = ctab[(c * m - cs * 32) & 127];
        const float4* rp = (const float4*)(tt + c * 32);
#pragma unroll
        for (int k4 = 0; k4 < 8; ++k4) {
          const float4 w = rp[k4];
          acc[4 * k4 + 0] += w.x * tr; acc[4 * k4 + 1] += w.y * tr; acc[4 * k4 + 2] += w.z * tr; acc[4 * k4 + 3] += w.w * tr;
        }
      }
      u16* dst = WTl(p, l) + (size_t)(2048 + cs * 512 + g * 128 + m) * 1024 + k0;
#pragma unroll
      for (int k8 = 0; k8 < 4; ++k8) {
        uint4 o;
        o.x = pk2(acc[8 * k8 + 0], acc[8 * k8 + 1]); o.y = pk2(acc[8 * k8 + 2], acc[8 * k8 + 3]);
        o.z = pk2(acc[8 * k8 + 4], acc[8 * k8 + 5]); o.w = pk2(acc[8 * k8 + 6], acc[8 * k8 + 7]);
        *(uint4*)(dst + 8 * k8) = o;
      }
      __syncthreads();
    }
  }
  if (part & 1) {
    const int gt = blockIdx.x * 256 + tid, gs = gridDim.x * 256;
    u16* CNK = (u16*)(p.ws + OFF_CNK);
    u16* CNVT = (u16*)(p.ws + OFF_CNVT);
    u16* CDK = (u16*)(p.ws + OFF_CDK);
    u16* CDVT = (u16*)(p.ws + OFF_CDVT);
    for (int i = gt; i < 524288; i += gs) {
      CNK[i] = f2bf(p.cna_k[i]);
      CDK[i] = f2bf(p.cdk[i]);
      {
        const int blh = i >> 14, t = (i >> 6) & 255, d = i & 63, q4 = (t >> 2) & 3;
        const int tp = (t & ~12) | ((q4 == 1 ? 2 : (q4 == 2 ? 1 : q4)) << 2);
        CNVT[(size_t)(blh * 64 + d) * 256 + tp] = f2bf(p.cna_v[i]);
      }
      {
        const int blh = i >> 15, t = (i >> 7) & 255, d = i & 127, q4 = (t >> 2) & 3;
        const int tp = (t & ~12) | ((q4 == 1 ? 2 : (q4 == 2 ? 1 : q4)) << 2);
        CDVT[(size_t)(blh * 128 + d) * 256 + tp] = f2bf(p.cdv[i]);
      }
    }
    u16* D1 = (u16*)(p.ws + OFF_D1);
    u16* D2 = (u16*)(p.ws + OFF_D2);
    u16* D256 = (u16*)(p.ws + OFF_D256);
    float2* TW = (float2*)(p.ws + OFF_TW);
    float2* ROPE = (float2*)(p.ws + OFF_ROPE);
    float* LAM = (float*)(p.ws + OFF_LAM);
    for (int i = gt; i < 128 * 128; i += gs) {
      const int row = i >> 7, col = i & 127, k1 = row & 63, ri = row >> 6, cs = col >> 6, r = col & 63;
      const int a = (r * k1) & 63;
      const float c = cospif(a * (1.f / 32.f)), s = sinpif(a * (1.f / 32.f));
      const float v = ri == 0 ? (cs == 0 ? c : -s) : (cs == 0 ? -s : -c);
      D1[i] = f2bf(v);
    }
    for (int i = gt; i < 64 * 128; i += gs) {
      const int k2 = i >> 7, col = i & 127, ri = col >> 6, q = col & 63;
      const int a = (q * k2) & 63;
      D2[i] = f2bf(ri == 0 ? cospif(a * (1.f / 32.f)) : sinpif(a * (1.f / 32.f)));
    }
    for (int i = gt; i < 256 * 512; i += gs) {
      const int k = i >> 9, col = i & 511, cs = col >> 8, t = col & 255;
      const int a = (t * k) & 255;
      D256[i] = f2bf(cs == 0 ? cospif(a * (1.f / 128.f)) : -sinpif(a * (1.f / 128.f)));
    }
    for (int i = gt; i < 4096; i += gs) {
      const int q = i >> 6, k1 = i & 63;
      const float a = (float)(q * k1) * (1.f / 2048.f);
      TW[i] = make_float2(cospif(a), sinpif(a));
    }
    for (int i = gt; i < 1024; i += gs) {
      const int pos = i >> 4, fi = i & 15;
      const float inv = powf(10000.f, -(float)fi * (1.f / 16.f));
      const float ang = (float)pos * inv;
      ROPE[i] = make_float2(cosf(ang), sinf(ang));
    }
    if (gt < 2) {
      const int l = gt;
      float s1 = 0.f, s2 = 0.f;
      for (int d = 0; d < 64; ++d) {
        s1 += p.lq1[l * 64 + d] * p.lk1[l * 64 + d];
        s2 += p.lq2[l * 64 + d] * p.lk2[l * 64 + d];
      }
      const float lam_init = 0.8f - 0.6f * expf(-0.3f * (float)l);
      LAM[l] = expf(s1) - expf(s2) + lam_init;
    }
  }
  if (part & 1) {
    float* sc = (float*)smem;
    float* red = sc + 3072;
    float* MOD = (float*)(p.ws + OFF_MOD);
    if (blockIdx.x < 384) {
      for (int i = tid; i < 3072; i += 256) {
        const int v = i >> 10, k = i & 1023;
        const float cv = v == 0 ? p.c_ctx[k] : p.c[(v - 1) * 1024 + k];
        sc[i] = silu_f(cv);
      }
      __syncthreads();
      for (int job = blockIdx.x; job < 384; job += gridDim.x) {
        const int l = job / 192, n0 = (job % 192) * 16, n = tid & 15, kq = tid >> 4;
        float a0 = 0.f, a1 = 0.f, a2 = 0.f;
        const float* w = p.w_mod + ((size_t)l * 1024 + kq * 64) * 3072 + n0 + n;
#pragma unroll
        for (int kb = 0; kb < 64; kb += 16) {
          float wv[16];
#pragma unroll
          for (int u = 0; u < 16; ++u) wv[u] = w[(size_t)(kb + u) * 3072];
#pragma unroll
          for (int u = 0; u < 16; ++u) {
            const int k = kq * 64 + kb + u;
            a0 += sc[k] * wv[u];
            a1 += sc[1024 + k] * wv[u];
            a2 += sc[2048 + k] * wv[u];
          }
        }
        red[(kq * 3 + 0) * 16 + n] = a0; red[(kq * 3 + 1) * 16 + n] = a1; red[(kq * 3 + 2) * 16 + n] = a2;
        __syncthreads();
        if (tid < 48) {
          const int v = tid >> 4, nn = tid & 15;
          float sum = p.b_mod[l * 3072 + n0 + nn];
#pragma unroll
          for (int q = 0; q < 16; ++q) sum += red[(q * 3 + v) * 16 + nn];
          MOD[(l * 3 + v) * 3072 + n0 + nn] = sum;
        }
        __syncthreads();
      }
    }
  }
}

DI void phase_h(const Params& p, int l) {
  const int lane = threadIdx.x & 63, wid = threadIdx.x >> 6;
  const float* ng = p.norm_g + l * 1024;
  u16* H = (u16*)(p.ws + OFF_H);
  const float* MOD = (const float*)(p.ws + OFF_MOD);
  for (int row = (blockIdx.x * 4 + wid) * 2; row < 12288; row += gridDim.x * 8) {
    const float* x0 = xin(p, l, row);
    const float* x1 = xin(p, l, row + 1);
    const float* mod = MOD + (l * 3 + vec_of(row)) * 3072;
    float4 xa[4], xb[4], g[4], sh[4], sl[4];
#pragma unroll
    for (int j = 0; j < 4; ++j) {
      xa[j] = *(const float4*)(x0 + j * 256 + lane * 4);
      xb[j] = *(const float4*)(x1 + j * 256 + lane * 4);
    }
#pragma unroll
    for (int j = 0; j < 4; ++j) {
      const int col = j * 256 + lane * 4;
      g[j] = *(const float4*)(ng + col);
      sh[j] = *(const float4*)(mod + col);
      sl[j] = *(const float4*)(mod + 1024 + col);
    }
    float sa = 0.f, sb = 0.f;
#pragma unroll
    for (int j = 0; j < 4; ++j) {
      sa += xa[j].x * xa[j].x + xa[j].y * xa[j].y + xa[j].z * xa[j].z + xa[j].w * xa[j].w;
      sb += xb[j].x * xb[j].x + xb[j].y * xb[j].y + xb[j].z * xb[j].z + xb[j].w * xb[j].w;
    }
#pragma unroll
    for (int o = 32; o; o >>= 1) {
      sa += __shfl_xor(sa, o);
      sb += __shfl_xor(sb, o);
    }
    const float ra = rsqrtf(sa * (1.f / 1024.f) + 1e-6f), rb = rsqrtf(sb * (1.f / 1024.f) + 1e-6f);
#pragma unroll
    for (int j = 0; j < 4; ++j) {
      const int col = j * 256 + lane * 4;
      const float m0 = g[j].x * (1.f + sl[j].x), m1 = g[j].y * (1.f + sl[j].y), m2 = g[j].z * (1.f + sl[j].z), m3 = g[j].w * (1.f + sl[j].w);
      *(uint2*)(H + (size_t)row * 1024 + col) =
          make_uint2(pk2(xa[j].x * ra * m0 + sh[j].x, xa[j].y * ra * m1 + sh[j].y), pk2(xa[j].z * ra * m2 + sh[j].z, xa[j].w * ra * m3 + sh[j].w));
      *(uint2*)(H + (size_t)(row + 1) * 1024 + col) =
          make_uint2(pk2(xb[j].x * rb * m0 + sh[j].x, xb[j].y * rb * m1 + sh[j].y), pk2(xb[j].z * rb * m2 + sh[j].z, xb[j].w * rb * m3 + sh[j].w));
    }
  }
}

DI void phase_win(const Params& p, int l, u16* smem) {
  const int tid = threadIdx.x, lane = tid & 63, wid = tid >> 6, wr = wid >> 1, wc = wid & 1, cl = lane & 31, hh = lane >> 5;
  const u16* wt = WTl(p, l);
  const u16* H = (const u16*)(p.ws + OFF_H);
  const float2* ROPE = (const float2*)(p.ws + OFF_ROPE);
  int ft, tt;
  for (int it = 0; xcd_map(it, 44, 96, 4, ft, tt); ++it) {
    const int f0 = ft * 128, seg = f0 >> 9;
    const bool sample = tt >= 32;
    const bool zmap = sample && (seg == 4 || seg == 5);
    const int ts = tt - 32;
    auto tokmap = [&](int c) -> int {
      if (!zmap) return tt * 128 + c;
      return 4096 + (ts >> 5) * 4096 + 64 * (c & 63) + 2 * (ts & 31) + (c >> 6);
    };
    f32x16 acc[2][2];
#pragma unroll
    for (int a = 0; a < 2; ++a)
#pragma unroll
      for (int b = 0; b < 2; ++b) zero16(acc[a][b]);
    const bool tr = (seg == 2 || seg == 4 || seg == 5 || seg == 9);
    if (tr)
      gemm_core<2>([&](int c) { return H + (size_t)tokmap(c) * 1024; }, [&](int r) { return wt + (size_t)(f0 + r) * 1024; }, 1024, acc, smem);
    else
      gemm_core<2>([&](int r) { return wt + (size_t)(f0 + r) * 1024; }, [&](int c) { return H + (size_t)tokmap(c) * 1024; }, 1024, acc, smem);
    const bool do_scale = (seg == 0 || seg == 7);
    const bool do_silu = (seg == 3 || seg == 6 || seg == 10);
    const bool do_rope = sample && (seg == 7 || seg == 8);
    const bool tr_v = (seg == 2 || seg == 9);
    const bool tr_z = (seg == 4 || seg == 5);
    float* cache_out = nullptr;
    int hshift = 6;
    if (!sample) {
      if (seg == 1) cache_out = p.out + OUT_NAK;
      else if (seg == 2) cache_out = p.out + OUT_NAV;
      else if (seg == 8) { cache_out = p.out + OUT_DK; hshift = 7; }
      else if (seg == 9) { cache_out = p.out + OUT_DV; hshift = 7; }
    }
    u16* segp = Pseg(p, seg);
    if (tr) {
      const int tile0 = tt * 128;
#pragma unroll
      for (int mi = 0; mi < 2; ++mi) {
#pragma unroll
        for (int ni = 0; ni < 2; ++ni) {
          const int f = (f0 & 511) + wc * 64 + ni * 32 + cl;
          size_t rowbase;
          if (!sample) rowbase = (size_t)((tile0 >> 8) * 512 + f) * 256 + (tile0 & 255) + wr * 64 + mi * 32;
          else if (tr_v) rowbase = (size_t)CTX_T + (size_t)(((tile0 - 4096) >> 12) * 512 + f) * 4096 + ((tile0 - 4096) & 4095) + wr * 64 + mi * 32;
          else rowbase = (size_t)CTX_T + ((size_t)((ts >> 5) * 512 + f) * 64 + 2 * (ts & 31) + wr) * 64 + mi * 32;
#pragma unroll
          for (int g = 0; g < 4; g += 2) {
            const uint2 qa = make_uint2(pk2(acc[mi][ni][4 * g], acc[mi][ni][4 * g + 1]), pk2(acc[mi][ni][4 * g + 2], acc[mi][ni][4 * g + 3]));
            const uint2 qb = make_uint2(pk2(acc[mi][ni][4 * g + 4], acc[mi][ni][4 * g + 5]), pk2(acc[mi][ni][4 * g + 6], acc[mi][ni][4 * g + 7]));
            if (tr_v)
              *(uint4*)(segp + rowbase + 8 * g + 8 * hh) = make_uint4(qa.x, qa.y, qb.x, qb.y);
            else
              store_pair16(segp + rowbase + 8 * g, qa, qb, hh);
          }
          if (cache_out) {
            const int b = tile0 >> 8, hd = f >> hshift, d = f & ((1 << hshift) - 1), nh = 512 >> hshift;
            float* dst = cache_out + ((size_t)((b * 2 + l) * nh + hd) * 256 + (tile0 & 255) + wr * 64 + mi * 32) * (1 << hshift) + d;
#pragma unroll
            for (int i = 0; i < 16; ++i) dst[(size_t)crow(i, hh) << hshift] = acc[mi][ni][i];
          }
        }
      }
      continue;
    }
#pragma unroll
    for (int mi = 0; mi < 2; ++mi) {
#pragma unroll
      for (int ni = 0; ni < 2; ++ni) {
        const int c = wc * 64 + ni * 32 + cl;
        const int tok = tokmap(c);
        const int fl = (f0 & 511) + wr * 64 + mi * 32 + 4 * hh;
        float v[16];
#pragma unroll
        for (int i = 0; i < 16; ++i) v[i] = acc[mi][ni][i];
        if (do_rope) {
          const int pos = (tok - 4096) & 4095;
          const int axis = mi == 0 ? (pos >> 6) : (pos & 63);
#pragma unroll
          for (int i = 0; i < 8; ++i) {
            const float2 cssn = ROPE[axis * 16 + crow(i, hh)];
            const float x1 = v[i], x2 = v[i + 8];
            v[i] = x1 * cssn.x - x2 * cssn.y;
            v[i + 8] = x2 * cssn.x + x1 * cssn.y;
          }
        }
        if (do_scale) {
#pragma unroll
          for (int i = 0; i < 16; ++i) v[i] *= QSCALE;
        }
        if (do_silu) {
#pragma unroll
          for (int i = 0; i < 16; ++i) v[i] = silu_f(v[i]);
        }
        if (tr_v || tr_z) {
          size_t base;
          int fstride;
          if (!sample) {
            const int b = tok >> 8, t = tok & 255;
            base = (size_t)(b * 512) * 256 + t; fstride = 256;
          } else {
            const int bs = (tok - 4096) >> 12, pos = (tok - 4096) & 4095;
            if (tr_v) { base = (size_t)CTX_T + (size_t)(bs * 512) * 4096 + pos; }
            else { base = (size_t)CTX_T + (size_t)(bs * 512) * 4096 + (pos & 63) * 64 + (pos >> 6); }
            fstride = 4096;
          }
#pragma unroll
          for (int i = 0; i < 16; ++i) {
            const int f = fl + (i & 3) + 8 * (i >> 2);
            segp[base + (size_t)f * fstride] = f2bf(v[i]);
          }
        } else {
#pragma unroll
          for (int g = 0; g < 4; g += 2) {
            store_pair16(segp + (size_t)tok * 512 + (fl - 4 * hh) + 8 * g, make_uint2(pk2(v[4 * g], v[4 * g + 1]), pk2(v[4 * g + 2], v[4 * g + 3])),
                         make_uint2(pk2(v[4 * g + 4], v[4 * g + 5]), pk2(v[4 * g + 6], v[4 * g + 7])), hh);
          }
        }
        if (cache_out) {
          const int b = tok >> 8, t = tok & 255;
#pragma unroll
          for (int g = 0; g < 4; ++g) {
            const int f = fl + 8 * g;
            const int hd = f >> hshift, d = f & ((1 << hshift) - 1);
            const int nh = 512 >> hshift;
            float* dst = cache_out + ((size_t)((b * 2 + l) * nh + hd) * 256 + t) * (1 << hshift) + d;
            *(float4*)dst = make_float4(v[4 * g], v[4 * g + 1], v[4 * g + 2], v[4 * g + 3]);
          }
        }
      }
    }
  }
}

constexpr int KS_LD = 136;
constexpr int VS_LD = 72;
DI void diff_block(const Params& p, int l, bool sample, int b, int h, int q64, u16* smem) {
  const int tid = threadIdx.x, lane = tid & 63, wid = tid >> 6, cl = lane & 31, hh = lane >> 5;
  const int qt = wid & 1, m = wid >> 1;
  const int tok = (sample ? 4096 + b * 4096 : b * 256) + q64 * 64 + qt * 32 + cl;
  u16* qseg = Pseg(p, 7);
  bf16x8 qf[4];
  {
    const u16* qp = qseg + (size_t)tok * 512 + h * 128 + m * 64 + hh * 8;
#pragma unroll
    for (int s = 0; s < 4; ++s) qf[s] = *(const bf16x8*)(qp + s * 16);
  }
  f32x16 O[4];
#pragma unroll
  for (int mt = 0; mt < 4; ++mt) zero16(O[mt]);
  float mr = -INFINITY, ls = 0.f;
  const int nt = sample ? 68 : 4, ncache = sample ? 4 : 0;
  const u16* kc = (const u16*)(p.ws + OFF_CDK) + (size_t)(((b * 2 + l) * 4 + h) * 256) * 128;
  const u16* vc = (const u16*)(p.ws + OFF_CDVT) + (size_t)(((b * 2 + l) * 4 + h) * 128) * 256;
  const u16* kl = Pseg(p, 8) + (size_t)(sample ? 4096 + b * 4096 : b * 256) * 512 + h * 128;
  const int vldl = sample ? 4096 : 256;
  const u16* vl = Pseg(p, 9) + (sample ? (size_t)CTX_T + (size_t)(b * 512 + h * 128) * 4096 : (size_t)(b * 512 + h * 128) * 256);
  u16* Ks = smem;
  u16* Vs = smem + 2 * 64 * KS_LD;
  uint4 rk[4], rv[4];
  unsigned ko[4], vo[4];
  auto set_offsets = [&](int kld, int vld) {
#pragma unroll
    for (int i = 0; i < 4; ++i) {
      const int e = tid + 256 * i;
      ko[i] = (unsigned)((e >> 4) * kld + (e & 15) * 8);
      vo[i] = (unsigned)((e >> 3) * vld + (e & 7) * 8);
    }
  };
  if (ncache) set_offsets(128, 256); else set_offsets(512, vldl);
  auto issue = [&](int t) {
    const u16 *kb, *vb;
    if (t < ncache) { kb = kc + (size_t)t * 64 * 128; vb = vc + t * 64; }
    else { kb = kl + (size_t)(t - ncache) * 64 * 512; vb = vl + (t - ncache) * 64; }
    if (ncache && t == ncache) set_offsets(512, vldl);
#pragma unroll
    for (int i = 0; i < 4; ++i) {
      rk[i] = *(const uint4*)(kb + ko[i]);
      rv[i] = *(const uint4*)(vb + vo[i]);
    }
  };
  auto stage = [&](int buf) {
#pragma unroll
    for (int i = 0; i < 4; ++i) {
      const int e = tid + 256 * i;
      *(uint4*)(Ks + buf * 64 * KS_LD + (e >> 4) * KS_LD + (e & 15) * 8) = rk[i];
      *(uint4*)(Vs + buf * 128 * VS_LD + (e >> 3) * VS_LD + (e & 7) * 8) = rv[i];
    }
  };
  issue(0);
  stage(0);
  __syncthreads();
  for (int t = 0; t < nt; ++t) {
    const int cur = t & 1;
    const bool more = t + 1 < nt;
    if (more) issue(t + 1);
    const u16* Kc = Ks + cur * 64 * KS_LD + cl * KS_LD + m * 64 + hh * 8;
    const u16* Vc = Vs + cur * 128 * VS_LD + cl * VS_LD + 8 * hh;
    f32x16 st0, st1;
    zero16(st0);
    zero16(st1);
#pragma unroll
    for (int s = 0; s < 4; ++s) {
      const bf16x8 a0 = *(const bf16x8*)(Kc + s * 16);
      const bf16x8 a1 = *(const bf16x8*)(Kc + 32 * KS_LD + s * 16);
      st0 = MFMA32(a0, qf[s], st0);
      st1 = MFMA32(a1, qf[s], st1);
    }
    float mx = fmax_nc(st0[0], st1[0]);
#pragma unroll
    for (int i = 1; i < 16; ++i) mx = fmax_nc(mx, fmax_nc(st0[i], st1[i]));
    mx = fmax_nc(mx, __shfl_xor(mx, 32));
    if (__any(mx > mr + 8.f)) {
      const float mnew = fmax_nc(mr, mx);
      const float alpha = ex2(mr - mnew);
      ls *= alpha;
#pragma unroll
      for (int mt = 0; mt < 4; ++mt)
#pragma unroll
        for (int i = 0; i < 16; ++i) O[mt][i] *= alpha;
      mr = mnew;
    }
    float sum = 0.f;
#pragma unroll
    for (int i = 0; i < 16; ++i) {
      st0[i] = ex2(st0[i] - mr);
      st1[i] = ex2(st1[i] - mr);
      sum += st0[i] + st1[i];
    }
    ls += sum;
    bf16x8 pf[4];
    pf[0] = pack8(st0, 0);
    pf[1] = pack8(st0, 1);
    pf[2] = pack8(st1, 0);
    pf[3] = pack8(st1, 1);
#pragma unroll
    for (int mt = 0; mt < 4; ++mt) {
#pragma unroll
      for (int s4 = 0; s4 < 4; ++s4) {
        const bf16x8 a = *(const bf16x8*)(Vc + mt * 32 * VS_LD + s4 * 16);
        O[mt] = MFMA32(a, pf[s4], O[mt]);
      }
    }
    if (more) stage(cur ^ 1);
    __syncthreads();
  }
  float* Cb = (float*)smem;
  const float lam = ((const float*)(p.ws + OFF_LAM))[l];
  const float lam_init = 0.8f - 0.6f * expf(-0.3f * (float)l);
  const float ltot = ls + __shfl_xor(ls, 32);
  if (m == 1) {
    const float sc = lam / ltot;
#pragma unroll
    for (int mt = 0; mt < 4; ++mt)
#pragma unroll
      for (int i = 0; i < 16; ++i) Cb[(qt * 64 + mt * 16 + i) * 64 + lane] = O[mt][i] * sc;
  }
  __syncthreads();
  if (m == 0) {
    const float i0 = 1.f / ltot;
    float ss = 0.f;
#pragma unroll
    for (int mt = 0; mt < 4; ++mt)
#pragma unroll
      for (int i = 0; i < 16; ++i) {
        const float o = O[mt][i] * i0 - Cb[(qt * 64 + mt * 16 + i) * 64 + lane];
        O[mt][i] = o;
        ss += o * o;
      }
    ss += __shfl_xor(ss, 32);
    const float rs = rsqrtf(ss * (1.f / 128.f) + 1e-6f) * (1.f - lam_init);
    const u16* zseg = Pseg(p, 10);
    const float* sg = p.subln_g + l * 128;
#pragma unroll
    for (int mt = 0; mt < 4; ++mt)
#pragma unroll
      for (int g = 0; g < 4; g += 2) {
        const int dvb = mt * 32 + 8 * g;
        const float4 ga = *(const float4*)(sg + dvb + 4 * hh), gb = *(const float4*)(sg + dvb + 8 + 4 * hh);
        uint2 za, zb;
        load_pair16(zseg + (size_t)tok * 512 + h * 128 + dvb, hh, za, zb);
        const float o0 = O[mt][4 * g + 0] * rs * ga.x * bf2f(za.x & 0xffffu);
        const float o1 = O[mt][4 * g + 1] * rs * ga.y * bf2f(za.x >> 16);
        const float o2 = O[mt][4 * g + 2] * rs * ga.z * bf2f(za.y & 0xffffu);
        const float o3 = O[mt][4 * g + 3] * rs * ga.w * bf2f(za.y >> 16);
        const float o4 = O[mt][4 * g + 4] * rs * gb.x * bf2f(zb.x & 0xffffu);
        const float o5 = O[mt][4 * g + 5] * rs * gb.y * bf2f(zb.x >> 16);
        const float o6 = O[mt][4 * g + 6] * rs * gb.z * bf2f(zb.y & 0xffffu);
        const float o7 = O[mt][4 * g + 7] * rs * gb.w * bf2f(zb.y >> 16);
        store_pair16(qseg + (size_t)tok * 512 + h * 128 + dvb, make_uint2(pk2(o0, o1), pk2(o2, o3)), make_uint2(pk2(o4, o5), pk2(o6, o7)), hh);
      }
  }
  __syncthreads();
}

constexpr int NA_LD = 72;
DI void na_block(const Params& p, int l, bool sample, int b, int h, int item, u16* smem) {
  const int tid = threadIdx.x, lane = tid & 63, wid = tid >> 6, cl = lane & 31, hh = lane >> 5;
  const int row = sample ? 2 * item + (wid >> 1) : 0;
  const int c0 = sample ? (wid & 1) * 32 : 0;
  const int tok = sample ? 4096 + b * 4096 + 64 * row + c0 + cl : b * 256 + item * 128 + wid * 32 + cl;
  u16* qseg = Pseg(p, 0);
  bf16x8 qf[4];
  {
    const u16* qp = qseg + (size_t)tok * 512 + h * 64 + hh * 8;
#pragma unroll
    for (int s = 0; s < 4; ++s) qf[s] = *(const bf16x8*)(qp + s * 16);
  }
  u16* Ks = smem;
  u16* Vs = smem + 2 * 64 * NA_LD;
  float* bt = (float*)(smem + 4 * 64 * NA_LD);
  if (sample) {
    const float* rp = p.na_rpb + (size_t)(l * 8 + h) * 465;
    for (int i = tid; i < 465; i += 256) bt[i] = rp[i] * LOG2E;
  }
  f32x16 O[2];
  zero16(O[0]);
  zero16(O[1]);
  float mr = -INFINITY, ls = 0.f;
  const u16 *kc, *vc;
  int kldc;
  if (sample) {
    kc = (const u16*)(p.ws + OFF_CNK) + (size_t)(((b * 2 + l) * 8 + h) * 256) * 64;
    vc = (const u16*)(p.ws + OFF_CNVT) + (size_t)(((b * 2 + l) * 8 + h) * 64) * 256;
    kldc = 64;
  } else {
    kc = Pseg(p, 1) + (size_t)(b * 256) * 512 + h * 64;
    vc = Pseg(p, 2) + (size_t)(b * 512 + h * 64) * 256;
    kldc = 512;
  }
  const u16* kl = Pseg(p, 1) + (size_t)(4096 + b * 4096) * 512 + h * 64;
  const u16* vl = Pseg(p, 2) + (size_t)CTX_T + (size_t)(b * 512 + h * 64) * 4096;
  const int rsA = min(max(2 * item - 4, 0), 56), rsB = min(max(2 * item - 3, 0), 56);
  const int nt = sample ? 4 + (rsB + 8 - rsA) : 4;
  const int rsw = min(max(row - 4, 0), 56);
  const int qc = c0 + cl, cs = min(max(qc - 8, 0), 48);
  uint4 rk0, rk1, rv0, rv1;
  const int e0 = tid, e1 = tid + 256;
#define NA_ISSUE(T)                                                                          \
  {                                                                                          \
    const u16 *ks_, *vs_;                                                                    \
    int kld_, vld_, key0_;                                                                   \
    if ((T) < 4) { ks_ = kc; kld_ = kldc; vs_ = vc; vld_ = 256; key0_ = (T) * 64; }          \
    else { ks_ = kl; kld_ = 512; vs_ = vl; vld_ = 4096; key0_ = (rsA + (T) - 4) * 64; }      \
    rk0 = *(const uint4*)(ks_ + (size_t)(key0_ + (e0 >> 3)) * kld_ + (e0 & 7) * 8);          \
    rk1 = *(const uint4*)(ks_ + (size_t)(key0_ + (e1 >> 3)) * kld_ + (e1 & 7) * 8);          \
    rv0 = *(const uint4*)(vs_ + (size_t)(e0 >> 3) * vld_ + key0_ + (e0 & 7) * 8);            \
    rv1 = *(const uint4*)(vs_ + (size_t)(e1 >> 3) * vld_ + key0_ + (e1 & 7) * 8);            \
  }
#define NA_STAGE1(E, RK, RV, BUF)                                                            \
  {                                                                                          \
    *(uint4*)(Ks + (BUF) * 64 * NA_LD + ((E) >> 3) * NA_LD + ((E) & 7) * 8) = RK;            \
    *(uint4*)(Vs + (BUF) * 64 * NA_LD + ((E) >> 3) * NA_LD + ((E) & 7) * 8) = RV;            \
  }
#define NA_STAGE(BUF) { NA_STAGE1(e0, rk0, rv0, BUF) NA_STAGE1(e1, rk1, rv1, BUF) }
  NA_ISSUE(0)
  NA_STAGE(0)
  __syncthreads();
  for (int t = 0; t < nt; ++t) {
    const int cur = t & 1;
    const bool more = t + 1 < nt;
    if (more) NA_ISSUE(t + 1)
    const int kr = rsA + t - 4;
    const bool local = t >= 4;
    const bool active = !local || (kr >= rsw && kr < rsw + 8);
    if (active) {
      const u16* Kc = Ks + cur * 64 * NA_LD + cl * NA_LD + hh * 8;
      const u16* Vc = Vs + cur * 64 * NA_LD + cl * NA_LD + 8 * hh;
      f32x16 st0, st1;
      zero16(st0);
      zero16(st1);
#pragma unroll
      for (int s = 0; s < 4; ++s) {
        const bf16x8 a0 = *(const bf16x8*)(Kc + s * 16);
        const bf16x8 a1 = *(const bf16x8*)(Kc + 32 * NA_LD + s * 16);
        st0 = MFMA32(a0, qf[s], st0);
        st1 = MFMA32(a1, qf[s], st1);
      }
      if (local) {
        const float* br = bt + (kr - row + 7) * 31;
#pragma unroll
        for (int i = 0; i < 16; ++i) {
          const int k0 = crow(i, hh), k1 = 32 + k0;
          const bool ok0 = (k0 >= cs) && (k0 < cs + 16), ok1 = (k1 >= cs) && (k1 < cs + 16);
          const int i0 = min(max(k0 - qc + 15, 0), 30), i1 = min(max(k1 - qc + 15, 0), 30);
          st0[i] = ok0 ? st0[i] + br[i0] : -INFINITY;
          st1[i] = ok1 ? st1[i] + br[i1] : -INFINITY;
        }
      }
      float mx = fmaxf(st0[0], st1[0]);
#pragma unroll
      for (int i = 1; i < 16; ++i) mx = fmaxf(mx, fmaxf(st0[i], st1[i]));
      mx = fmaxf(mx, __shfl_xor(mx, 32));
      if (__any(mx > mr + 8.f)) {
        const float mnew = fmaxf(mr, mx);
        const float alpha = ex2(mr - mnew);
        ls *= alpha;
#pragma unroll
        for (int i = 0; i < 16; ++i) {
          O[0][i] *= alpha;
          O[1][i] *= alpha;
        }
        mr = mnew;
      }
      float sum = 0.f;
#pragma unroll
      for (int i = 0; i < 16; ++i) {
        st0[i] = ex2(st0[i] - mr);
        st1[i] = ex2(st1[i] - mr);
        sum += st0[i] + st1[i];
      }
      ls += sum;
      bf16x8 pf[4];
      pf[0] = pack8(st0, 0);
      pf[1] = pack8(st0, 1);
      pf[2] = pack8(st1, 0);
      pf[3] = pack8(st1, 1);
#pragma unroll
      for (int mt = 0; mt < 2; ++mt)
#pragma unroll
        for (int s4 = 0; s4 < 4; ++s4) {
          const bf16x8 a = *(const bf16x8*)(Vc + mt * 32 * NA_LD + s4 * 16);
          O[mt] = MFMA32(a, pf[s4], O[mt]);
        }
    }
    if (more) NA_STAGE(cur ^ 1)
    __syncthreads();
  }
#undef NA_ISSUE
#undef NA_STAGE1
#undef NA_STAGE
  const float linv = 1.f / (ls + __shfl_xor(ls, 32));
  const u16* zseg = Pseg(p, 3);
  uint2 zz[2][4];
#pragma unroll
  for (int mt = 0; mt < 2; ++mt)
#pragma unroll
    for (int g = 0; g < 4; g += 2) load_pair16(zseg + (size_t)tok * 512 + h * 64 + mt * 32 + 8 * g, hh, zz[mt][g], zz[mt][g + 1]);
#pragma unroll
  for (int mt = 0; mt < 2; ++mt)
#pragma unroll
    for (int g = 0; g < 4; g += 2) {
      const int dv = mt * 32 + 8 * g;
      const float o0 = O[mt][4 * g + 0] * linv * bf2f(zz[mt][g].x & 0xffffu);
      const float o1 = O[mt][4 * g + 1] * linv * bf2f(zz[mt][g].x >> 16);
      const float o2 = O[mt][4 * g + 2] * linv * bf2f(zz[mt][g].y & 0xffffu);
      const float o3 = O[mt][4 * g + 3] * linv * bf2f(zz[mt][g].y >> 16);
      const float o4 = O[mt][4 * g + 4] * linv * bf2f(zz[mt][g + 1].x & 0xffffu);
      const float o5 = O[mt][4 * g + 5] * linv * bf2f(zz[mt][g + 1].x >> 16);
      const float o6 = O[mt][4 * g + 6] * linv * bf2f(zz[mt][g + 1].y & 0xffffu);
      const float o7 = O[mt][4 * g + 7] * linv * bf2f(zz[mt][g + 1].y >> 16);
      store_pair16(qseg + (size_t)tok * 512 + h * 64 + dv, make_uint2(pk2(o0, o1), pk2(o2, o3)), make_uint2(pk2(o4, o5), pk2(o6, o7)), hh);
    }
}

template <int NT>
DI void frag_gemm_t(const u16* a0, const u16* a1, const u16* bp  , int b_nt_stride, int halfsteps, f32x16 (&acc)[NT]) {
  for (int half = 0; half < 2; ++half) {
    const u16* ap = half ? a1 : a0;
    const u16* bq = bp + half * halfsteps * 16;
    for (int s = 0; s < halfsteps; ++s) {
      const bf16x8 av = *(const bf16x8*)(ap + s * 16);
#pragma unroll
      for (int nt = 0; nt < NT; ++nt) {
        const bf16x8 bv = *(const bf16x8*)(bq + (size_t)nt * b_nt_stride + s * 16);
        acc[nt] = MFMA32(av, bv, acc[nt]);
      }
    }
  }
}

DI void fnet_stage1_item(const Params& p, int b, int ct) {
  const int lane = threadIdx.x & 63, cl = lane & 31, hh = lane >> 5;
  const int ch = ct >> 1, qh = ct & 1;
  const u16* D1 = (const u16*)(p.ws + OFF_D1);
  const size_t zoff = (size_t)CTX_T + ((size_t)(b * 512 + ch) * 64 + qh * 32 + cl) * 64 + hh * 8;
  f32x16 acc[4];
#pragma unroll
  for (int nt = 0; nt < 4; ++nt) zero16(acc[nt]);
  frag_gemm_t<4>(Pseg(p, 4) + zoff, Pseg(p, 5) + zoff, D1 + (size_t)cl * 128 + hh * 8, 32 * 128, 4, acc);
  const float2* TW = (const float2*)(p.ws + OFF_TW);
  u16* AT = (u16*)(p.ws + OFF_AT);
#pragma unroll
  for (int j = 0; j < 2; ++j) {
    const int k1 = 32 * j + cl;
    u16* dre = AT + ((size_t)((b * 2 + 0) * 512 + ch)) * 4096 + k1 * 64 + qh * 32;
    u16* dim = AT + ((size_t)((b * 2 + 1) * 512 + ch)) * 4096 + k1 * 64 + qh * 32;
#pragma unroll
    for (int g = 0; g < 4; g += 2) {
      float re2[8], im2[8];
#pragma unroll
      for (int e = 0; e < 8; ++e) {
        const int i = 4 * g + e;
        const float2 tw = TW[(qh * 32 + crow(i, hh)) * 64 + k1];
        const float re = acc[j][i], im = acc[j + 2][i];
        re2[e] = re * tw.x + im * tw.y;
        im2[e] = im * tw.x - re * tw.y;
      }
      store_pair16(dre + 8 * g, make_uint2(pk2(re2[0], re2[1]), pk2(re2[2], re2[3])), make_uint2(pk2(re2[4], re2[5]), pk2(re2[6], re2[7])), hh);
      store_pair16(dim + 8 * g, make_uint2(pk2(im2[0], im2[1]), pk2(im2[2], im2[3])), make_uint2(pk2(im2[4], im2[5]), pk2(im2[6], im2[7])), hh);
    }
  }
}

DI void fnet_ctx_item(const Params& p, int b, int cht, int rh) {
  const int lane = threadIdx.x & 63, cl = lane & 31, hh = lane >> 5;
  const u16* D256 = (const u16*)(p.ws + OFF_D256);
  const size_t zoff = (size_t)(b * 512 + cht * 32 + cl) * 256 + hh * 8;
  f32x16 acc[4];
#pragma unroll
  for (int nt = 0; nt < 4; ++nt) zero16(acc[nt]);
  frag_gemm_t<4>(Pseg(p, 4) + zoff, Pseg(p, 5) + zoff, D256 + (size_t)(rh * 128 + cl) * 512 + hh * 8, 32 * 512, 16, acc);
  u16* F = (u16*)(p.ws + OFF_F);
  const float sc = 0.00552427172801990f;
#pragma unroll
  for (int nt = 0; nt < 4; ++nt) {
    const int k = rh * 128 + nt * 32 + cl;
    u16* dst = F + (size_t)(b * 256 + k) * 512 + cht * 32;
#pragma unroll
    for (int g = 0; g < 4; g += 2)
      store_pair16(dst + 8 * g, make_uint2(pk2(acc[nt][4 * g] * sc, acc[nt][4 * g + 1] * sc), pk2(acc[nt][4 * g + 2] * sc, acc[nt][4 * g + 3] * sc)),
                   make_uint2(pk2(acc[nt][4 * g + 4] * sc, acc[nt][4 * g + 5] * sc), pk2(acc[nt][4 * g + 6] * sc, acc[nt][4 * g + 7] * sc)), hh);
  }
}

DI void fnet_stage2_item(const Params& p, int b, int k1, int cht) {
  const int lane = threadIdx.x & 63, cl = lane & 31, hh = lane >> 5;
  const int ch = cht * 32 + cl;
  const u16* D2 = (const u16*)(p.ws + OFF_D2);
  const u16* AT = (const u16*)(p.ws + OFF_AT);
  f32x16 acc[2];
  zero16(acc[0]);
  zero16(acc[1]);
  frag_gemm_t<2>(AT + ((size_t)((b * 2 + 0) * 512 + ch)) * 4096 + k1 * 64 + hh * 8, AT + ((size_t)((b * 2 + 1) * 512 + ch)) * 4096 + k1 * 64 + hh * 8,
                 D2 + (size_t)cl * 128 + hh * 8, 32 * 128, 4, acc);
  u16* F = (u16*)(p.ws + OFF_F);
  const float sc = 0.00138106793200498f;
#pragma unroll
  for (int nt = 0; nt < 2; ++nt) {
    const int k2 = nt * 32 + cl;
    u16* dst = F + (size_t)(4096 + b * 4096 + k1 + 64 * k2) * 512 + cht * 32;
#pragma unroll
    for (int g = 0; g < 4; g += 2)
      store_pair16(dst + 8 * g, make_uint2(pk2(acc[nt][4 * g] * sc, acc[nt][4 * g + 1] * sc), pk2(acc[nt][4 * g + 2] * sc, acc[nt][4 * g + 3] * sc)),
                   make_uint2(pk2(acc[nt][4 * g + 4] * sc, acc[nt][4 * g + 5] * sc), pk2(acc[nt][4 * g + 6] * sc, acc[nt][4 * g + 7] * sc)), hh);
  }
}

DI void phase_mixA(const Params& p, int l, u16* smem) {
  const int gw = blockIdx.x * 4 + (threadIdx.x >> 6), nw = gridDim.x * 4;
  for (int it = blockIdx.x; it < 768; it += gridDim.x) {
    const bool smp = it < 512;
    const int j = smp ? it : it - 512;
    const int b = smp ? ((j & 7) >> 2) : (j >> 4), h = smp ? (j & 3) : ((j >> 2) & 3), q64 = smp ? (j >> 3) : (j & 3);
    diff_block(p, l, smp, b, h, q64, smem);
  }
  for (int it = gridDim.x - 1 - blockIdx.x; it < 768; it += gridDim.x) {
    const bool smp = it < 512;
    const int j = smp ? it : it - 512;
    const int bh = smp ? ((j & 7) * 2 + (j >> 8)) : 0;
    const int b = smp ? (bh >> 3) : (j >> 4), h = smp ? (bh & 7) : ((j >> 1) & 7), qi = smp ? ((j >> 3) & 31) : (j & 1);
    na_block(p, l, smp, b, h, qi, smem);
  }
  for (int it = nw - 1 - gw; it < 2560; it += nw) {
    if (it < 2048) fnet_stage1_item(p, it >> 10, it & 1023);
    else { const int j = it - 2048; fnet_ctx_item(p, j >> 5, (j >> 1) & 15, j & 1); }
  }
}

DI void phase_mixB(const Params& p) {
  const int gw = blockIdx.x * 4 + (threadIdx.x >> 6), nw = gridDim.x * 4;
  for (int it = gw; it < 2048; it += nw) fnet_stage2_item(p, it >> 10, (it >> 4) & 63, it & 15);
}

DI void phase_fnetw(const Params& p, int l, u16* smem) {
  const int tid = threadIdx.x, lane = tid & 63, wid = tid >> 6, wr = wid >> 1, wc = wid & 1, cl = lane & 31, hh = lane >> 5;
  const u16* wf = (const u16*)(p.ws + OFF_WF) + (size_t)l * 512 * 512;
  const u16* F = (const u16*)(p.ws + OFF_F);
  u16* zs = Pseg(p, 6);
  int ft, tt;
  for (int it = 0; xcd_map(it, 4, 96, 1, ft, tt); ++it) {
    const int f0 = ft * 128, t0 = tt * 128;
    f32x16 acc[2][2];
#pragma unroll
    for (int a = 0; a < 2; ++a)
#pragma unroll
      for (int b = 0; b < 2; ++b) zero16(acc[a][b]);
    gemm_core<2>([&](int r) { return wf + (size_t)(f0 + r) * 512; }, [&](int c) { return F + (size_t)(t0 + c) * 512; }, 512, acc, smem);
#pragma unroll
    for (int ni = 0; ni < 2; ++ni) {
      const int tok = t0 + wc * 64 + ni * 32 + cl;
      uint2 zz[2][4];
#pragma unroll
      for (int mi = 0; mi < 2; ++mi)
#pragma unroll
        for (int g = 0; g < 4; g += 2) load_pair16(zs + (size_t)tok * 512 + f0 + wr * 64 + mi * 32 + 8 * g, hh, zz[mi][g], zz[mi][g + 1]);
#pragma unroll
      for (int mi = 0; mi < 2; ++mi)
#pragma unroll
        for (int g = 0; g < 4; g += 2) {
          const int f = f0 + wr * 64 + mi * 32 + 8 * g;
          const float o0 = acc[mi][ni][4 * g + 0] * bf2f(zz[mi][g].x & 0xffffu), o1 = acc[mi][ni][4 * g + 1] * bf2f(zz[mi][g].x >> 16);
          const float o2 = acc[mi][ni][4 * g + 2] * bf2f(zz[mi][g].y & 0xffffu), o3 = acc[mi][ni][4 * g + 3] * bf2f(zz[mi][g].y >> 16);
          const float o4 = acc[mi][ni][4 * g + 4] * bf2f(zz[mi][g + 1].x & 0xffffu), o5 = acc[mi][ni][4 * g + 5] * bf2f(zz[mi][g + 1].x >> 16);
          const float o6 = acc[mi][ni][4 * g + 6] * bf2f(zz[mi][g + 1].y & 0xffffu), o7 = acc[mi][ni][4 * g + 7] * bf2f(zz[mi][g + 1].y >> 16);
          store_pair16(zs + (size_t)tok * 512 + f, make_uint2(pk2(o0, o1), pk2(o2, o3)), make_uint2(pk2(o4, o5), pk2(o6, o7)), hh);
        }
    }
  }
}

DI int sig_seg(int b, int half) { return b == 0 ? 1 + half : (b == 1 ? 8 + half : (half ? 10 : 3)); }
DI void phase_gates(const Params& p, int l, u16* smem) {
  const int tid = threadIdx.x, lane = tid & 63, wid = tid >> 6, wr = wid >> 1, wc = wid & 1, cl = lane & 31, hh = lane >> 5;
  const u16* wt = WTl(p, l) + (size_t)5632 * 1024;
  const u16* H = (const u16*)(p.ws + OFF_H);
  int ft, tt;
  for (int it = 0; xcd_map(it, 24, 96, 4, ft, tt); ++it) {
    const int n0 = ft * 128, t0 = tt * 128;
    f32x16 acc[2][2];
#pragma unroll
    for (int a = 0; a < 2; ++a)
#pragma unroll
      for (int b = 0; b < 2; ++b) zero16(acc[a][b]);
    gemm_core<2>([&](int r) { return wt + (size_t)(n0 + r) * 1024; }, [&](int c) { return H + (size_t)(t0 + c) * 1024; }, 1024, acc, smem);
    const int bb = n0 >> 10, f = n0 & 1023;
    u16* dstseg = Pseg(p, sig_seg(bb, f >> 9));
#pragma unroll
    for (int ni = 0; ni < 2; ++ni) {
      const int tok = t0 + wc * 64 + ni * 32 + cl;
#pragma unroll
      for (int mi = 0; mi < 2; ++mi)
#pragma unroll
        for (int g = 0; g < 4; g += 2) {
          const int fc = (f & 511) + wr * 64 + mi * 32 + 8 * g;
          store_pair16(dstseg + (size_t)tok * 512 + fc,
                       make_uint2(pk2(sigmoid_f(acc[mi][ni][4 * g]), sigmoid_f(acc[mi][ni][4 * g + 1])),
                                  pk2(sigmoid_f(acc[mi][ni][4 * g + 2]), sigmoid_f(acc[mi][ni][4 * g + 3]))),
                       make_uint2(pk2(sigmoid_f(acc[mi][ni][4 * g + 4]), sigmoid_f(acc[mi][ni][4 * g + 5])),
                                  pk2(sigmoid_f(acc[mi][ni][4 * g + 6]), sigmoid_f(acc[mi][ni][4 * g + 7]))), hh);
        }
    }
  }
}

DI void phase_merge(const Params& p, int l, u16* smem) {
  const int tid = threadIdx.x, lane = tid & 63, wid = tid >> 6, wr = wid >> 1, wc = wid & 1, cl = lane & 31, hh = lane >> 5;
  const u16* WB = (const u16*)(p.ws + OFF_WB) + (size_t)l * 3 * 1024 * 512;
  u16* Y = Pseg(p, 4);
  int ft, tt;
  for (int it = 0; xcd_map(it, 8, 96, 2, ft, tt); ++it) {
    const int f0 = ft * 128, t0 = tt * 128;
    f32x16 y[2][2];
#pragma unroll
    for (int a = 0; a < 2; ++a)
#pragma unroll
      for (int b = 0; b < 2; ++b) zero16(y[a][b]);
#pragma unroll 1
    for (int b = 0; b < 3; ++b) {
      f32x16 au[2][2];
#pragma unroll
      for (int a = 0; a < 2; ++a)
#pragma unroll
        for (int c = 0; c < 2; ++c) zero16(au[a][c]);
      const u16* U = Pseg(p, b == 0 ? 0 : (b == 1 ? 6 : 7));
      const u16* wb = WB + (size_t)b * 1024 * 512;
      gemm_core<2, false>([&](int r) { return wb + (size_t)(f0 + r) * 512; }, [&](int c) { return U + (size_t)(t0 + c) * 512; }, 512, au, smem);
      const u16* sg = Pseg(p, sig_seg(b, f0 >> 9));
#pragma unroll
      for (int ni = 0; ni < 2; ++ni) {
        const int tok = t0 + wc * 64 + ni * 32 + cl;
#pragma unroll
        for (int mi = 0; mi < 2; ++mi)
#pragma unroll
          for (int g = 0; g < 4; g += 2) {
            const int fc = (f0 & 511) + wr * 64 + mi * 32 + 8 * g;
            uint2 za, zb;
            load_pair16(sg + (size_t)tok * 512 + fc, hh, za, zb);
            y[mi][ni][4 * g + 0] += au[mi][ni][4 * g + 0] * bf2f(za.x & 0xffffu);
            y[mi][ni][4 * g + 1] += au[mi][ni][4 * g + 1] * bf2f(za.x >> 16);
            y[mi][ni][4 * g + 2] += au[mi][ni][4 * g + 2] * bf2f(za.y & 0xffffu);
            y[mi][ni][4 * g + 3] += au[mi][ni][4 * g + 3] * bf2f(za.y >> 16);
            y[mi][ni][4 * g + 4] += au[mi][ni][4 * g + 4] * bf2f(zb.x & 0xffffu);
            y[mi][ni][4 * g + 5] += au[mi][ni][4 * g + 5] * bf2f(zb.x >> 16);
            y[mi][ni][4 * g + 6] += au[mi][ni][4 * g + 6] * bf2f(zb.y & 0xffffu);
            y[mi][ni][4 * g + 7] += au[mi][ni][4 * g + 7] * bf2f(zb.y >> 16);
          }
      }
    }
#pragma unroll
    for (int ni = 0; ni < 2; ++ni) {
      const int tok = t0 + wc * 64 + ni * 32 + cl;
#pragma unroll
      for (int mi = 0; mi < 2; ++mi)
#pragma unroll
        for (int g = 0; g < 4; g += 2) {
          const int f = f0 + wr * 64 + mi * 32 + 8 * g;
          store_pair16(Y + (size_t)tok * 1024 + f, make_uint2(pk2(y[mi][ni][4 * g], y[mi][ni][4 * g + 1]), pk2(y[mi][ni][4 * g + 2], y[mi][ni][4 * g + 3])),
                       make_uint2(pk2(y[mi][ni][4 * g + 4], y[mi][ni][4 * g + 5]), pk2(y[mi][ni][4 * g + 6], y[mi][ni][4 * g + 7])), hh);
        }
    }
  }
}

DI void phase_wout(const Params& p, int l, u16* smem) {
  const int tid = threadIdx.x, lane = tid & 63, wid = tid >> 6, wr = wid >> 1, wc = wid & 1, cl = lane & 31, hh = lane >> 5;
  const u16* wo = (const u16*)(p.ws + OFF_WO) + (size_t)l * 1024 * 1024;
  const u16* Y = Pseg(p, 4);
  const float* MOD = (const float*)(p.ws + OFF_MOD);
  int ft, tt;
  for (int it = 0; xcd_map(it, 8, 96, 2, ft, tt); ++it) {
    const int f0 = ft * 128, t0 = tt * 128;
    f32x16 acc[2][2];
#pragma unroll
    for (int a = 0; a < 2; ++a)
#pragma unroll
      for (int b = 0; b < 2; ++b) zero16(acc[a][b]);
    gemm_core<2>([&](int r) { return wo + (size_t)(f0 + r) * 1024; }, [&](int c) { return Y + (size_t)(t0 + c) * 1024; }, 1024, acc, smem);
#pragma unroll
    for (int ni = 0; ni < 2; ++ni) {
      const int tok = t0 + wc * 64 + ni * 32 + cl;
      const float* xr = xin(p, l, tok);
      const float* gate = MOD + (l * 3 + vec_of(tok)) * 3072 + 2048;
      float* orow = p.out + (size_t)tok * 1024;
      float4 xv[2][4], gv[2][4];
#pragma unroll
      for (int mi = 0; mi < 2; ++mi)
#pragma unroll
        for (int g = 0; g < 4; ++g) {
          const int f = f0 + wr * 64 + mi * 32 + 4 * hh + 8 * g;
          xv[mi][g] = *(const float4*)(xr + f);
          gv[mi][g] = *(const float4*)(gate + f);
        }
#pragma unroll
      for (int mi = 0; mi < 2; ++mi)
#pragma unroll
        for (int g = 0; g < 4; ++g) {
          const int f = f0 + wr * 64 + mi * 32 + 4 * hh + 8 * g;
          float4 o;
          o.x = xv[mi][g].x + gv[mi][g].x * acc[mi][ni][4 * g + 0];
          o.y = xv[mi][g].y + gv[mi][g].y * acc[mi][ni][4 * g + 1];
          o.z = xv[mi][g].z + gv[mi][g].z * acc[mi][ni][4 * g + 2];
          o.w = xv[mi][g].w + gv[mi][g].w * acc[mi][ni][4 * g + 3];
          *(float4*)(orow + f) = o;
        }
    }
  }
}

DI void phase_final(const Params& p) {
  const int lane = threadIdx.x & 63, wid = threadIdx.x >> 6;
  for (int row = (blockIdx.x * 4 + wid) * 2; row < 12288; row += gridDim.x * 8) {
    float* x0 = p.out + (size_t)row * 1024;
    float* x1 = x0 + 1024;
    float4 xa[4], xb[4], g[4];
#pragma unroll
    for (int j = 0; j < 4; ++j) {
      xa[j] = *(const float4*)(x0 + j * 256 + lane * 4);
      xb[j] = *(const float4*)(x1 + j * 256 + lane * 4);
      g[j] = *(const float4*)(p.final_g + j * 256 + lane * 4);
    }
    float sa = 0.f, sb = 0.f;
#pragma unroll
    for (int j = 0; j < 4; ++j) {
      sa += xa[j].x * xa[j].x + xa[j].y * xa[j].y + xa[j].z * xa[j].z + xa[j].w * xa[j].w;
      sb += xb[j].x * xb[j].x + xb[j].y * xb[j].y + xb[j].z * xb[j].z + xb[j].w * xb[j].w;
    }
#pragma unroll
    for (int o = 32; o; o >>= 1) {
      sa += __shfl_xor(sa, o);
      sb += __shfl_xor(sb, o);
    }
    const float ra = rsqrtf(sa * (1.f / 1024.f) + 1e-6f), rb = rsqrtf(sb * (1.f / 1024.f) + 1e-6f);
#pragma unroll
    for (int j = 0; j < 4; ++j) {
      const int col = j * 256 + lane * 4;
      *(float4*)(x0 + col) = make_float4(xa[j].x * ra * g[j].x, xa[j].y * ra * g[j].y, xa[j].z * ra * g[j].z, xa[j].w * ra * g[j].w);
      *(float4*)(x1 + col) = make_float4(xb[j].x * rb * g[j].x, xb[j].y * rb * g[j].y, xb[j].z * rb * g[j].z, xb[j].w * rb * g[j].w);
    }
  }
}

#define XB_TMO      128
#define XB_XCNT(j)  (256  + 64 * (j))
#define XB_XSUB(j)  (1280 + 64 * (j))
#define XB_XGEN(j)  (2304 + 64 * (j))
#define XB_TOP      3328
#define XB_TOPGEN   3392
#define XB_SPIN_CAP (1u << 18)
#define LAS __attribute__((address_space(3)))
DI unsigned xb_ld(unsigned* p) { return __hip_atomic_load(p, __ATOMIC_RELAXED, __HIP_MEMORY_SCOPE_AGENT); }
DI unsigned xb_add(unsigned* p, unsigned v) { return __hip_atomic_fetch_add(p, v, __ATOMIC_RELAXED, __HIP_MEMORY_SCOPE_AGENT); }
DI unsigned xb_xcc_id() { return (unsigned)__builtin_amdgcn_s_getreg((3 << 11) | 20) & 0xFu; }
#define XB_SPIN(cond, bar) do { unsigned _sp = 0; while (cond) { __builtin_amdgcn_s_sleep(1); \
    if ((++_sp & 255u) == 0u) { if (xb_ld(&(bar)[XB_TMO])) break; if (_sp > XB_SPIN_CAP) { atomicAdd(&(bar)[XB_TMO], 1u); break; } } } } while (0)
struct XcdBarrier {
  unsigned* bar;
  unsigned x;
  volatile LAS unsigned* st;
};
DI XcdBarrier xcd_barrier_post(unsigned* bar, volatile LAS unsigned* st) {
  XcdBarrier b;
  b.bar = bar;
  b.x = xb_xcc_id();
  b.st = st;
  if (threadIdx.x == 0) (void)xb_add(&bar[XB_XCNT(b.x)], 1u);
  return b;
}
DI void xcd_barrier_complete(unsigned* bar, unsigned x, unsigned& nloc, unsigned& nx) {
  const unsigned G = gridDim.x * gridDim.y * gridDim.z;
  unsigned sum, cnt, mine, sp = 0u;
  for (;;) {
    sum = 0u; cnt = 0u; mine = 0u;
#pragma unroll
    for (unsigned j = 0; j < 16; ++j) {
      const unsigned c = xb_ld(&bar[XB_XCNT(j)]);
      sum += c;
      cnt += (c > 0u) ? 1u : 0u;
      mine = (j == x) ? c : mine;
    }
    if (sum == G) break;
    __builtin_amdgcn_s_sleep(1);
    if ((++sp & 255u) == 0u) {
      if (xb_ld(&bar[XB_TMO])) break;
      if (sp > XB_SPIN_CAP) { atomicAdd(&bar[XB_TMO], 1u); break; }
    }
  }
  nloc = mine > 0u ? mine : 1u;
  nx = cnt > 0u ? cnt : 1u;
}
DI void xcd_barrier(const XcdBarrier& b) {
  asm volatile("s_waitcnt vmcnt(0)" ::: "memory");
  __syncthreads();
  if (threadIdx.x == 0) {
    unsigned* bar = b.bar;
    __builtin_amdgcn_s_waitcnt(0);
    unsigned nloc = b.st[0], nx = b.st[1];
    if (nloc == 0u) {
      xcd_barrier_complete(bar, b.x, nloc, nx);
      b.st[0] = nloc;
      b.st[1] = nx;
    }
    const unsigned old = xb_add(&bar[XB_XSUB(b.x)], 1u);
    const unsigned gen = old / nloc;
    if (old + 1u == (gen + 1u) * nloc) {
      __builtin_amdgcn_fence(__ATOMIC_RELEASE, "agent");
      asm volatile("s_waitcnt vmcnt(0)" ::: "memory");
      const unsigned og = xb_add(&bar[XB_TOP], 1u);
      const unsigned tg = og / nx;
      if (og + 1u == (tg + 1u) * nx) xb_add(&bar[XB_TOPGEN], 1u);
      else XB_SPIN(xb_ld(&bar[XB_TOPGEN]) == tg, bar);
      __builtin_amdgcn_fence(__ATOMIC_ACQUIRE, "agent");
      xb_add(&bar[XB_XGEN(b.x)], 1u);
      asm volatile("s_waitcnt vmcnt(0)" ::: "memory");
    } else {
      XB_SPIN(xb_ld(&bar[XB_XGEN(b.x)]) == gen, bar);
      __builtin_amdgcn_fence(__ATOMIC_ACQUIRE, "agent");
      asm volatile("s_waitcnt vmcnt(0)" ::: "memory");
    }
  }
  __syncthreads();
}

constexpr int SMEM_BYTES = (2 * 128 * LDT + 2 * 128 * LDT) * 2;

__global__ void __launch_bounds__(256, 2) fwd_megakernel(Params p, int ph_lo, int ph_hi, int use_cg) {
  __shared__ __attribute__((aligned(16))) char smem[SMEM_BYTES];
  __shared__ uint4 xb_words;
  cg::grid_group grid = cg::this_grid();
  if (threadIdx.x == 0) xb_words = make_uint4(0u, 0u, 0u, 0u);
  __syncthreads();
  XcdBarrier xb = xcd_barrier_post((unsigned*)(p.ws + OFF_BAR), (volatile LAS unsigned*)&xb_words);
#define GRID_SYNC() do { if (use_cg) grid.sync(); else xcd_barrier(xb); } while (0)
#define RUN_PHASE(PH, CALL)                       \
  if (ph_lo <= (PH) && (PH) < ph_hi) {            \
    CALL;                                         \
    if ((PH) + 1 < ph_hi) GRID_SYNC();            \
  }
#define RUN_LAYER(L)                                                                           \
  RUN_PHASE(1 + 7 * (L) + 0, { phase_h(p, (L)); if ((L) == 0) phase_prep(p, smem, 2); })        \
  RUN_PHASE(1 + 7 * (L) + 1, phase_win(p, (L), (u16*)smem))                                    \
  RUN_PHASE(1 + 7 * (L) + 2, phase_mixA(p, (L), (u16*)smem))                                   \
  RUN_PHASE(1 + 7 * (L) + 3, { phase_mixB(p); phase_gates(p, (L), (u16*)smem); })              \
  RUN_PHASE(1 + 7 * (L) + 4, phase_fnetw(p, (L), (u16*)smem))                                  \
  RUN_PHASE(1 + 7 * (L) + 5, phase_merge(p, (L), (u16*)smem))                                  \
  RUN_PHASE(1 + 7 * (L) + 6, phase_wout(p, (L), (u16*)smem))
  RUN_PHASE(0, phase_prep(p, smem, 1))
  RUN_LAYER(0)
  RUN_LAYER(1)
  RUN_PHASE(15, phase_final(p))
}

extern "C" void kernel_launch(void* const* d_in, const int* in_sizes, int n_in, void* d_out, int out_size, void* d_ws, size_t ws_size,
                              hipStream_t stream) {
  static int grid_blocks = 0;
  if (!grid_blocks) {
    int dev = 0, cus = 0, per_cu = 0;
    hipGetDevice(&dev);
    hipDeviceGetAttribute(&cus, hipDeviceAttributeMultiprocessorCount, dev);
    hipOccupancyMaxActiveBlocksPerMultiprocessor(&per_cu, fwd_megakernel, 256, 0);
    if (per_cu > 2) per_cu = 2;
    if (per_cu < 1) per_cu = 1;
    grid_blocks = cus * per_cu;
  }
  Params p{};
  const float** pp = (const float**)&p;
  for (int i = 0; i < 22; ++i) pp[i] = (const float*)d_in[i];
  p.out = (float*)d_out;
  p.ws = (char*)d_ws;
  int lo = 0, hi = 16, use_cg = 0;
  hipMemsetAsync((char*)d_ws + OFF_BAR, 0, BAR_BYTES, stream);
  void* args[] = {&p, &lo, &hi, &use_cg};
  hipError_t e = hipLaunchCooperativeKernel((void*)fwd_megakernel, dim3(grid_blocks), dim3(256), args, 0, stream);
  if (e != hipSuccess) fprintf(stderr, "cooperative launch failed: %s (grid %d)\n", hipGetErrorString(e), grid_blocks);
}
```

```cpp
#include <hip/hip_runtime.h>
#include <hip/hip_cooperative_groups.h>
#include <cstdio>
namespace cg = cooperative_groups;

typedef unsigned short u16;
using bf16x8 = __attribute__((ext_vector_type(8))) short;
using s16x4  = __attribute__((ext_vector_type(4))) short;
using f32x16 = __attribute__((ext_vector_type(16))) float;
typedef __attribute__((ext_vector_type(2))) float f32x2_t;
typedef __attribute__((ext_vector_type(2))) __bf16 bf16x2_t;

#define DI __device__ __forceinline__
#define MFMA32(a, b, c) __builtin_amdgcn_mfma_f32_32x32x16_bf16((a), (b), (c), 0, 0, 0)

struct Params {
  const float *x_prompt, *x_sample, *cna_k, *cna_v, *cdk, *cdv, *c, *c_ctx, *norm_g, *w_mod, *b_mod, *w_in, *na_rpb, *fnet_w,
      *lq1, *lk1, *lq2, *lk2, *subln_g, *w_branch, *w_out, *final_g;
  float* out;
  char* ws;
};

constexpr size_t SEGE = 12288ull * 512ull;
constexpr size_t SEGB = SEGE * 2;
constexpr size_t OFF_P = 0;
constexpr size_t OFF_WT = OFF_P + 11 * SEGB;
constexpr size_t WT_L = 8704ull * 1024ull;
constexpr size_t OFF_WB = OFF_WT + 2 * WT_L * 2;
constexpr size_t OFF_WO = OFF_WB + 2ull * 3 * 1024 * 512 * 2;
constexpr size_t OFF_WF = OFF_WO + 2ull * 1024 * 1024 * 2;
constexpr size_t OFF_H = OFF_WF + 2ull * 512 * 512 * 2;
constexpr size_t OFF_F = OFF_H + 12288ull * 1024 * 2;
constexpr size_t OFF_AT = OFF_F + SEGB;
constexpr size_t OFF_CNK = OFF_AT + 2ull * 2 * 512 * 4096 * 2;
constexpr size_t OFF_CNVT = OFF_CNK + 524288ull * 2;
constexpr size_t OFF_CDK = OFF_CNVT + 524288ull * 2;
constexpr size_t OFF_CDVT = OFF_CDK + 524288ull * 2;
constexpr size_t OFF_D1 = OFF_CDVT + 524288ull * 2;
constexpr size_t OFF_D2 = OFF_D1 + 128 * 128 * 2;
constexpr size_t OFF_D256 = OFF_D2 + 64 * 128 * 2;
constexpr size_t OFF_TW = OFF_D256 + 256 * 512 * 2;
constexpr size_t OFF_ROPE = OFF_TW + 4096 * 8;
constexpr size_t OFF_MOD = OFF_ROPE + 1024 * 8;
constexpr size_t OFF_LAM = OFF_MOD + 2 * 3 * 3072 * 4;
constexpr size_t OFF_BAR = OFF_LAM + 256;
constexpr size_t BAR_BYTES = 3456 * 4;
constexpr size_t WS_END = OFF_BAR + BAR_BYTES;
static_assert(WS_END <= 268435456ull, "workspace too large");

constexpr int CTX_T = 2097152;
constexpr float QSCALE = 0.125f * 1.44269504088896f;
constexpr float LOG2E = 1.44269504088896f;

constexpr size_t OUT_NAK = 12582912, OUT_NAV = 16777216, OUT_DK = 20971520, OUT_DV = 25165824;

DI unsigned pk2(float a, float b) {
  bf16x2_t q = __builtin_convertvector((f32x2_t){a, b}, bf16x2_t);
  return __builtin_bit_cast(unsigned, q);
}
DI u16 f2bf(float a) { return (u16)(pk2(a, 0.f) & 0xffffu); }
DI float bf2f(unsigned v) { return __uint_as_float(v << 16); }
DI int crow(int i, int hh) { return (i & 3) + 8 * (i >> 2) + 4 * hh; }
DI float silu_f(float x) { return x / (1.f + __expf(-x)); }
DI float sigmoid_f(float x) { return 1.f / (1.f + __expf(-x)); }
DI float ex2(float x) { return __builtin_amdgcn_exp2f(x); }
DI float fmax_nc(float a, float b) { return __builtin_amdgcn_fmed3f(a, b, __builtin_inff()); }

DI u16* Pseg(const Params& p, int s) { return (u16*)(p.ws + OFF_P) + (size_t)s * SEGE; }
DI u16* WTl(const Params& p, int l) { return (u16*)(p.ws + OFF_WT) + (size_t)l * WT_L; }
DI const float* xin(const Params& p, int l, int tok) {
  if (l == 0) return tok < 4096 ? p.x_prompt + (size_t)tok * 1024 : p.x_sample + (size_t)(tok - 4096) * 1024;
  return p.out + (size_t)tok * 1024;
}
DI int vec_of(int tok) { return tok < 4096 ? 0 : 1 + ((tok - 4096) >> 12); }

DI void zero16(f32x16& a) {
#pragma unroll
  for (int i = 0; i < 16; ++i) a[i] = 0.f;
}
DI bf16x8 pack8(const f32x16& x, int s) {
  unsigned a = pk2(x[8 * s], x[8 * s + 1]), b = pk2(x[8 * s + 2], x[8 * s + 3]), c = pk2(x[8 * s + 4], x[8 * s + 5]),
           d = pk2(x[8 * s + 6], x[8 * s + 7]);
  uint4 u = make_uint4(a, b, c, d);
  return __builtin_bit_cast(bf16x8, u);
}

DI void store_pair16(u16* p_g  , uint2 a, uint2 b, int hh) {
  const auto r0 = __builtin_amdgcn_permlane32_swap(a.x, b.x, false, false);
  const auto r1 = __builtin_amdgcn_permlane32_swap(a.y, b.y, false, false);
  *(uint4*)(p_g + 8 * hh) = make_uint4(r0[0], r1[0], r0[1], r1[1]);
}

DI void load_pair16(const u16* p_g  , int hh, uint2& a, uint2& b) {
  const uint4 L = *(const uint4*)(p_g + 8 * hh);
  const auto r0 = __builtin_amdgcn_permlane32_swap(L.x, L.z, false, false);
  const auto r1 = __builtin_amdgcn_permlane32_swap(L.y, L.w, false, false);
  a = make_uint2(r0[0], r1[0]);
  b = make_uint2(r0[1], r1[1]);
}

constexpr int LDT = 72;
template <int NI, bool IGLP = true>
DI void g_compute(const u16* Ac, const u16* Bc, f32x16 (&acc)[2][NI]) {
  if (IGLP) __builtin_amdgcn_iglp_opt(0);
#pragma unroll
  for (int s = 0; s < 4; ++s) {
    const bf16x8 a0 = *(const bf16x8*)(Ac + s * 16);
    const bf16x8 a1 = *(const bf16x8*)(Ac + 32 * LDT + s * 16);
    bf16x8 b[NI];
#pragma unroll
    for (int ni = 0; ni < NI; ++ni) b[ni] = *(const bf16x8*)(Bc + ni * 32 * LDT + s * 16);
#pragma unroll
    for (int ni = 0; ni < NI; ++ni) {
      acc[0][ni] = MFMA32(a0, b[ni], acc[0][ni]);
      acc[1][ni] = MFMA32(a1, b[ni], acc[1][ni]);
    }
  }
}
template <int NI, bool PF2 = true, class FA, class FB>
DI void gemm_core(FA arow, FB brow, int K, f32x16 (&acc)[2][NI], u16* smem) {
  u16* As = smem;
  u16* Bs = smem + 2 * 128 * LDT;
  const int tid = threadIdx.x, lane = tid & 63, wid = tid >> 6, wr = wid >> 1, wc = wid & 1;
  const int lrow = tid >> 3, lchk = (tid & 7) * 8;
  const int cl = lane & 31, hh = lane >> 5;
  const u16* pa0 = arow(lrow) + lchk;
  const u16* pa1 = arow(lrow + 32) + lchk;
  const u16* pa2 = arow(lrow + 64) + lchk;
  const u16* pa3 = arow(lrow + 96) + lchk;
  const u16* pb0 = brow(lrow) + lchk;
  const u16* pb1 = brow(lrow + 32) + lchk;
  const u16* pb2 = NI == 2 ? brow(lrow + 64) + lchk : pb0;
  const u16* pb3 = NI == 2 ? brow(lrow + 96) + lchk : pb0;
  const int nk = K >> 6;
  const u16* Ac0 = As + (wr * 64 + cl) * LDT + hh * 8;
  const u16* Bc0 = Bs + (wc * 32 * NI + cl) * LDT + hh * 8;
  u16* Aw = As + lrow * LDT + lchk;
  u16* Bw = Bs + lrow * LDT + lchk;
  uint4 x0, x1, x2, x3, x4, x5, x6, x7;
  uint4 y0, y1, y2, y3, y4, y5, y6, y7;
#define GL(P, OFF) (*(const uint4*)((P) + (OFF)))
#define GLOAD0(OFF)                                                                   \
  x0 = GL(pa0, OFF); x1 = GL(pa1, OFF); x2 = GL(pa2, OFF); x3 = GL(pa3, OFF);          \
  x4 = GL(pb0, OFF); x5 = GL(pb1, OFF);                                                \
  if (NI == 2) { x6 = GL(pb2, OFF); x7 = GL(pb3, OFF); }
#define GLOAD1(OFF)                                                                   \
  y0 = GL(pa0, OFF); y1 = GL(pa1, OFF); y2 = GL(pa2, OFF); y3 = GL(pa3, OFF);          \
  y4 = GL(pb0, OFF); y5 = GL(pb1, OFF);                                                \
  if (NI == 2) { y6 = GL(pb2, OFF); y7 = GL(pb3, OFF); }
#define GS(P, V) (*(uint4*)(P) = (V))
#define GSTORE0(AB, BB)                                                               \
  GS((AB), x0); GS((AB) + 32 * LDT, x1); GS((AB) + 64 * LDT, x2); GS((AB) + 96 * LDT, x3); \
  GS((BB), x4); GS((BB) + 32 * LDT, x5);                                               \
  if (NI == 2) { GS((BB) + 64 * LDT, x6); GS((BB) + 96 * LDT, x7); }
#define GSTORE1(AB, BB)                                                               \
  GS((AB), y0); GS((AB) + 32 * LDT, y1); GS((AB) + 64 * LDT, y2); GS((AB) + 96 * LDT, y3); \
  GS((BB), y4); GS((BB) + 32 * LDT, y5);                                               \
  if (NI == 2) { GS((BB) + 64 * LDT, y6); GS((BB) + 96 * LDT, y7); }
  if (!PF2) {
    GLOAD0(0)
    GSTORE0(Aw, Bw)
    __syncthreads();
    for (int kt = 0; kt < nk; ++kt) {
      const int cur = kt & 1;
      const bool more = kt + 1 < nk;
      if (more) { GLOAD0((kt + 1) * 64) }
      g_compute<NI, false>(Ac0 + cur * 128 * LDT, Bc0 + cur * 64 * NI * LDT, acc);
      if (more) { GSTORE0(Aw + (cur ^ 1) * 128 * LDT, Bw + (cur ^ 1) * 64 * NI * LDT) }
      __syncthreads();
    }
    return;
  }
  GLOAD0(0)
  GSTORE0(Aw, Bw)
  GLOAD1(64)
  __syncthreads();
  for (int kt = 0; kt < nk; kt += 2) {
    const int k2 = (kt + 2) * 64;
    const bool m2 = kt + 2 < nk;
    if (m2) { GLOAD0(k2) }
    __builtin_amdgcn_sched_barrier(0);
    g_compute<NI>(Ac0, Bc0, acc);
    GSTORE1(Aw + 128 * LDT, Bw + 64 * NI * LDT)
    __syncthreads();
    if (m2) { GLOAD1(k2 + 64) }
    __builtin_amdgcn_sched_barrier(0);
    g_compute<NI>(Ac0 + 128 * LDT, Bc0 + 64 * NI * LDT, acc);
    if (m2) { GSTORE0(Aw, Bw) }
    __syncthreads();
  }
#undef GL
#undef GS
#undef GLOAD0
#undef GLOAD1
#undef GSTORE0
#undef GSTORE1
}

DI bool xcd_map(int it, int NF, int NT, int GXF, int& ft, int& tt) {
  const int x = blockIdx.x & 7, j = blockIdx.x >> 3, nb = gridDim.x >> 3;
  const int GXT = 8 / GXF, Fx = NF / GXF, Tx = NT / GXT;
  const int idx = j + it * nb;
  if (idx >= Fx * Tx) return false;
  ft = (x % GXF) * Fx + idx % Fx;
  tt = (x / GXF) * Tx + idx / Fx;
  return true;
}

DI void phase_prep(const Params& p, char* smem, int part) {
  const int tid = threadIdx.x;
  u16* WB = (u16*)(p.ws + OFF_WB);
  u16* WO = (u16*)(p.ws + OFF_WO);
  u16* WF = (u16*)(p.ws + OFF_WF);
  if (part & 2) {
    float* t = (float*)smem;
    for (int job = blockIdx.x; job < 5248; job += gridDim.x) {
      const float* src;
      u16* dst;
      int ldsrc, lddst, k0, ns0, nd0;
      int j = job;
      if (j < 3840) {
        const int l = j / 1920;
        j %= 1920;
        const int nt = j >> 4, kt = j & 15;
        const int nd = nt < 32 ? nt * 64 : 3072 + (nt - 32) * 64;
        const int nsrc = nt < 32 ? nd : nd - 512;
        src = p.w_in + (size_t)l * 1024 * 8192; ldsrc = 8192; dst = WTl(p, l); lddst = 1024; k0 = kt * 64; ns0 = nsrc; nd0 = nd;
      } else if (j < 4608) {
        j -= 3840;
        const int lb = j >> 7;
        j &= 127;
        const int nt = j >> 3, kt = j & 7;
        src = p.w_branch + (size_t)lb * 512 * 1024; ldsrc = 1024; dst = WB + (size_t)lb * 1024 * 512; lddst = 512; k0 = kt * 64; ns0 = nd0 = nt * 64;
      } else if (j < 5120) {
        j -= 4608;
        const int l = j >> 8;
        j &= 255;
        const int nt = j >> 4, kt = j & 15;
        src = p.w_out + (size_t)l * 1024 * 1024; ldsrc = 1024; dst = WO + (size_t)l * 1024 * 1024; lddst = 1024; k0 = kt * 64; ns0 = nd0 = nt * 64;
      } else {
        j -= 5120;
        const int l = j >> 6;
        j &= 63;
        const int nt = j >> 3, kt = j & 7;
        src = p.fnet_w + (size_t)l * 512 * 512; ldsrc = 512; dst = WF + (size_t)l * 512 * 512; lddst = 512; k0 = kt * 64; ns0 = nd0 = nt * 64;
      }
#pragma unroll
      for (int i = 0; i < 4; ++i) {
        const int row = (tid >> 4) + 16 * i, c4 = (tid & 15) * 4;
        const float4 v = *(const float4*)(src + (size_t)(k0 + row) * ldsrc + ns0 + c4);
        t[row * 65 + c4 + 0] = v.x; t[row * 65 + c4 + 1] = v.y; t[row * 65 + c4 + 2] = v.z; t[row * 65 + c4 + 3] = v.w;
      }
      __syncthreads();
#pragma unroll
      for (int i = 0; i < 2; ++i) {
        const int n = (tid >> 3) + 32 * i, kk = (tid & 7) * 8;
        uint4 o;
        o.x = pk2(t[(kk + 0) * 65 + n], t[(kk + 1) * 65 + n]);
        o.y = pk2(t[(kk + 2) * 65 + n], t[(kk + 3) * 65 + n]);
        o.z = pk2(t[(kk + 4) * 65 + n], t[(kk + 5) * 65 + n]);
        o.w = pk2(t[(kk + 6) * 65 + n], t[(kk + 7) * 65 + n]);
        *(uint4*)(dst + (size_t)(nd0 + n) * lddst + k0 + kk) = o;
      }
      __syncthreads();
    }
  }
  if (part & 2) {
    float* tt = (float*)smem;
    float* ctab = tt + 128 * 32;
    for (int job = blockIdx.x; job < 256; job += gridDim.x) {
      const int l = job >> 7, g = (job >> 5) & 3, k0 = (job & 31) * 32;
      if (tid < 128) ctab[tid] = cospif((float)tid * (1.f / 64.f));
#pragma unroll
      for (int i = 0; i < 4; ++i) {
        const int idx = tid + 256 * i, row = idx >> 5, c4 = (idx & 31) * 4;
        const float4 v = *(const float4*)(p.w_in + ((size_t)l * 1024 + k0 + row) * 8192 + 2048 + g * 128 + c4);
        tt[(c4 + 0) * 32 + row] = v.x; tt[(c4 + 1) * 32 + row] = v.y; tt[(c4 + 2) * 32 + row] = v.z; tt[(c4 + 3) * 32 + row] = v.w;
      }
      __syncthreads();
      const int m = tid & 127, cs = tid >> 7;
      float acc[32];
#pragma unroll
      for (int k = 0; k < 32; ++k) acc[k] = 0.f;
      for (int c = 0; c < 128; ++c) {
        const float tr = ctab[(c * m - cs * 32) & 127];
        const float4* rp = (const float4*)(tt + c * 32);
#pragma unroll
        for (int k4 = 0; k4 < 8; ++k4) {
          const float4 w = rp[k4];
          acc[4 * k4 + 0] += w.x * tr; acc[4 * k4 + 1] += w.y * tr; acc[4 * k4 + 2] += w.z * tr; acc[4 * k4 + 3] += w.w * tr;
        }
      }
      u16* dst = WTl(p, l) + (size_t)(2048 + cs * 512 + g * 128 + m) * 1024 + k0;
#pragma unroll
      for (int k8 = 0; k8 < 4; ++k8) {
        uint4 o;
        o.x = pk2(acc[8 * k8 + 0], acc[8 * k8 + 1]); o.y = pk2(acc[8 * k8 + 2], acc[8 * k8 + 3]);
        o.z = pk2(acc[8 * k8 + 4], acc[8 * k8 + 5]); o.w = pk2(acc[8 * k8 + 6], acc[8 * k8 + 7]);
        *(uint4*)(dst + 8 * k8) = o;
      }
      __syncthreads();
    }
  }
  if (part & 1) {
    const int gt = blockIdx.x * 256 + tid, gs = gridDim.x * 256;
    u16* CNK = (u16*)(p.ws + OFF_CNK);
    u16* CNVT = (u16*)(p.ws + OFF_CNVT);
    u16* CDK = (u16*)(p.ws + OFF_CDK);
    u16* CDVT = (u16*)(p.ws + OFF_CDVT);
    for (int i = gt; i < 524288; i += gs) {
      CNK[i] = f2bf(p.cna_k[i]);
      CDK[i] = f2bf(p.cdk[i]);
      const int tp = i & 255, q4 = (tp >> 2) & 3;
      const int t = (tp & ~12) | ((q4 == 1 ? 2 : (q4 == 2 ? 1 : q4)) << 2);
      {
        const int blh = i >> 14, d = (i >> 8) & 63;
        CNVT[i] = f2bf(p.cna_v[(size_t)(blh * 256 + t) * 64 + d]);
      }
      {
        const int blh = i >> 15, d = (i >> 8) & 127;
        CDVT[i] = f2bf(p.cdv[(size_t)(blh * 256 + t) * 128 + d]);
      }
    }
    u16* D1 = (u16*)(p.ws + OFF_D1);
    u16* D2 = (u16*)(p.ws + OFF_D2);
    u16* D256 = (u16*)(p.ws + OFF_D256);
    float2* TW = (float2*)(p.ws + OFF_TW);
    float2* ROPE = (float2*)(p.ws + OFF_ROPE);
    float* LAM = (float*)(p.ws + OFF_LAM);
    for (int i = gt; i < 128 * 128; i += gs) {
      const int row = i >> 7, col = i & 127, k1 = row & 63, ri = row >> 6, cs = col >> 6, r = col & 63;
      const int a = (r * k1) & 63;
      const float c = cospif(a * (1.f / 32.f)), s = sinpif(a * (1.f / 32.f));
      const float v = ri == 0 ? (cs == 0 ? c : -s) : (cs == 0 ? -s : -c);
      D1[i] = f2bf(v);
    }
    for (int i = gt; i < 64 * 128; i += gs) {
      const int k2 = i >> 7, col = i & 127, ri = col >> 6, q = col & 63;
      const int a = (q * k2) & 63;
      D2[i] = f2bf(ri == 0 ? cospif(a * (1.f / 32.f)) : sinpif(a * (1.f / 32.f)));
    }
    for (int i = gt; i < 256 * 512; i += gs) {
      const int k = i >> 9, col = i & 511, cs = col >> 8, t = col & 255;
      const int a = (t * k) & 255;
      D256[i] = f2bf(cs == 0 ? cospif(a * (1.f / 128.f)) : -sinpif(a * (1.f / 128.f)));
    }
    for (int i = gt; i < 4096; i += gs) {
      const int q = i >> 6, k1 = i & 63;
      const float a = (float)(q * k1) * (1.f / 2048.f);
      TW[i] = make_float2(cospif(a), sinpif(a));
    }
    for (int i = gt; i < 1024; i += gs) {
      const int pos = i >> 4, fi = i & 15;
      const float inv = powf(10000.f, -(float)fi * (1.f / 16.f));
      const float ang = (float)pos * inv;
      ROPE[i] = make_float2(cosf(ang), sinf(ang));
    }
    if (gt < 2) {
      const int l = gt;
      float s1 = 0.f, s2 = 0.f;
      for (int d = 0; d < 64; ++d) {
        s1 += p.lq1[l * 64 + d] * p.lk1[l * 64 + d];
        s2 += p.lq2[l * 64 + d] * p.lk2[l * 64 + d];
      }
      const float lam_init = 0.8f - 0.6f * expf(-0.3f * (float)l);
      LAM[l] = expf(s1) - expf(s2) + lam_init;
    }
  }
  if (part & 1) {
    float* sc = (float*)smem;
    float* red = sc + 3072;
    float* MOD = (float*)(p.ws + OFF_MOD);
    if (blockIdx.x < 384) {
      for (int i = tid; i < 3072; i += 256) {
        const int v = i >> 10, k = i & 1023;
        const float cv = v == 0 ? p.c_ctx[k] : p.c[(v - 1) * 1024 + k];
        sc[i] = silu_f(cv);
      }
      __syncthreads();
      for (int job = blockIdx.x; job < 384; job += gridDim.x) {
        const int l = job / 192, n0 = (job % 192) * 16, n = tid & 15, kq = tid >> 4;
        float a0 = 0.f, a1 = 0.f, a2 = 0.f;
        const float* w = p.w_mod + ((size_t)l * 1024 + kq * 64) * 3072 + n0 + n;
#pragma unroll
        for (int kb = 0; kb < 64; kb += 16) {
          float wv[16];
#pragma unroll
          for (int u = 0; u < 16; ++u) wv[u] = w[(size_t)(kb + u) * 3072];
#pragma unroll
          for (int u = 0; u < 16; ++u) {
            const int k = kq * 64 + kb + u;
            a0 += sc[k] * wv[u];
            a1 += sc[1024 + k] * wv[u];
            a2 += sc[2048 + k] * wv[u];
          }
        }
        red[(kq * 3 + 0) * 16 + n] = a0; red[(kq * 3 + 1) * 16 + n] = a1; red[(kq * 3 + 2) * 16 + n] = a2;
        __syncthreads();
        if (tid < 48) {
          const int v = tid >> 4, nn = tid & 15;
          float sum = p.b_mod[l * 3072 + n0 + nn];
#pragma unroll
          for (int q = 0; q < 16; ++q) sum += red[(q * 3 + v) * 16 + nn];
          MOD[(l * 3 + v) * 3072 + n0 + nn] = sum;
        }
        __syncthreads();
      }
    }
  }
}

DI void phase_h(const Params& p, int l) {
  const int lane = threadIdx.x & 63, wid = threadIdx.x >> 6;
  const float* ng = p.norm_g + l * 1024;
  u16* H = (u16*)(p.ws + OFF_H);
  const float* MOD = (const float*)(p.ws + OFF_MOD);
  for (int row = (blockIdx.x * 4 + wid) * 2; row < 12288; row += gridDim.x * 8) {
    const float* x0 = xin(p, l, row);
    const float* x1 = xin(p, l, row + 1);
    const float* mod = MOD + (l * 3 + vec_of(row)) * 3072;
    float4 xa[4], xb[4], g[4], sh[4], sl[4];
#pragma unroll
    for (int j = 0; j < 4; ++j) {
      xa[j] = *(const float4*)(x0 + j * 256 + lane * 4);
      xb[j] = *(const float4*)(x1 + j * 256 + lane * 4);
    }
#pragma unroll
    for (int j = 0; j < 4; ++j) {
      const int col = j * 256 + lane * 4;
      g[j] = *(const float4*)(ng + col);
      sh[j] = *(const float4*)(mod + col);
      sl[j] = *(const float4*)(mod + 1024 + col);
    }
    float sa = 0.f, sb = 0.f;
#pragma unroll
    for (int j = 0; j < 4; ++j) {
      sa += xa[j].x * xa[j].x + xa[j].y * xa[j].y + xa[j].z * xa[j].z + xa[j].w * xa[j].w;
      sb += xb[j].x * xb[j].x + xb[j].y * xb[j].y + xb[j].z * xb[j].z + xb[j].w * xb[j].w;
    }
#pragma unroll
    for (int o = 32; o; o >>= 1) {
      sa += __shfl_xor(sa, o);
      sb += __shfl_xor(sb, o);
    }
    const float ra = rsqrtf(sa * (1.f / 1024.f) + 1e-6f), rb = rsqrtf(sb * (1.f / 1024.f) + 1e-6f);
#pragma unroll
    for (int j = 0; j < 4; ++j) {
      const int col = j * 256 + lane * 4;
      const float m0 = g[j].x * (1.f + sl[j].x), m1 = g[j].y * (1.f + sl[j].y), m2 = g[j].z * (1.f + sl[j].z), m3 = g[j].w * (1.f + sl[j].w);
      *(uint2*)(H + (size_t)row * 1024 + col) =
          make_uint2(pk2(xa[j].x * ra * m0 + sh[j].x, xa[j].y * ra * m1 + sh[j].y), pk2(xa[j].z * ra * m2 + sh[j].z, xa[j].w * ra * m3 + sh[j].w));
      *(uint2*)(H + (size_t)(row + 1) * 1024 + col) =
          make_uint2(pk2(xb[j].x * rb * m0 + sh[j].x, xb[j].y * rb * m1 + sh[j].y), pk2(xb[j].z * rb * m2 + sh[j].z, xb[j].w * rb * m3 + sh[j].w));
    }
  }
}

DI void phase_win(const Params& p, int l, u16* smem) {
  const int tid = threadIdx.x, lane = tid & 63, wid = tid >> 6, wr = wid >> 1, wc = wid & 1, cl = lane & 31, hh = lane >> 5;
  const u16* wt = WTl(p, l);
  const u16* H = (const u16*)(p.ws + OFF_H);
  const float2* ROPE = (const float2*)(p.ws + OFF_ROPE);
  int ft, tt;
  for (int it = 0; xcd_map(it, 44, 96, 4, ft, tt); ++it) {
    const int f0 = ft * 128, seg = f0 >> 9;
    const bool sample = tt >= 32;
    const bool zmap = sample && (seg == 4 || seg == 5);
    const int ts = tt - 32;
    auto tokmap = [&](int c) -> int {
      if (!zmap) return tt * 128 + c;
      return 4096 + (ts >> 5) * 4096 + 64 * (c & 63) + 2 * (ts & 31) + (c >> 6);
    };
    f32x16 acc[2][2];
#pragma unroll
    for (int a = 0; a < 2; ++a)
#pragma unroll
      for (int b = 0; b < 2; ++b) zero16(acc[a][b]);
    const bool tr = (seg == 2 || seg == 4 || seg == 5 || seg == 9);
    if (tr)
      gemm_core<2>([&](int c) { return H + (size_t)tokmap(c) * 1024; }, [&](int r) { return wt + (size_t)(f0 + r) * 1024; }, 1024, acc, smem);
    else
      gemm_core<2>([&](int r) { return wt + (size_t)(f0 + r) * 1024; }, [&](int c) { return H + (size_t)tokmap(c) * 1024; }, 1024, acc, smem);
    const bool do_scale = (seg == 0 || seg == 7);
    const bool do_silu = (seg == 3 || seg == 6 || seg == 10);
    const bool do_rope = sample && (seg == 7 || seg == 8);
    const bool tr_v = (seg == 2 || seg == 9);
    const bool tr_z = (seg == 4 || seg == 5);
    float* cache_out = nullptr;
    int hshift = 6;
    if (!sample) {
      if (seg == 1) cache_out = p.out + OUT_NAK;
      else if (seg == 2) cache_out = p.out + OUT_NAV;
      else if (seg == 8) { cache_out = p.out + OUT_DK; hshift = 7; }
      else if (seg == 9) { cache_out = p.out + OUT_DV; hshift = 7; }
    }
    u16* segp = Pseg(p, seg);
    if (tr) {
      const int tile0 = tt * 128;
#pragma unroll
      for (int mi = 0; mi < 2; ++mi) {
#pragma unroll
        for (int ni = 0; ni < 2; ++ni) {
          const int f = (f0 & 511) + wc * 64 + ni * 32 + cl;
          size_t rowbase;
          if (!sample) rowbase = (size_t)((tile0 >> 8) * 512 + f) * 256 + (tile0 & 255) + wr * 64 + mi * 32;
          else if (tr_v) rowbase = (size_t)CTX_T + (size_t)(((tile0 - 4096) >> 12) * 512 + f) * 4096 + ((tile0 - 4096) & 4095) + wr * 64 + mi * 32;
          else rowbase = (size_t)CTX_T + ((size_t)((ts >> 5) * 512 + f) * 64 + 2 * (ts & 31) + wr) * 64 + mi * 32;
#pragma unroll
          for (int g = 0; g < 4; g += 2) {
            const uint2 qa = make_uint2(pk2(acc[mi][ni][4 * g], acc[mi][ni][4 * g + 1]), pk2(acc[mi][ni][4 * g + 2], acc[mi][ni][4 * g + 3]));
            const uint2 qb = make_uint2(pk2(acc[mi][ni][4 * g + 4], acc[mi][ni][4 * g + 5]), pk2(acc[mi][ni][4 * g + 6], acc[mi][ni][4 * g + 7]));
            if (tr_v)
              *(uint4*)(segp + rowbase + 8 * g + 8 * hh) = make_uint4(qa.x, qa.y, qb.x, qb.y);
            else
              store_pair16(segp + rowbase + 8 * g, qa, qb, hh);
          }
          if (cache_out) {
            const int b = tile0 >> 8, hd = f >> hshift, d = f & ((1 << hshift) - 1), nh = 512 >> hshift;
            float* dst = cache_out + ((size_t)((b * 2 + l) * nh + hd) * 256 + (tile0 & 255) + wr * 64 + mi * 32) * (1 << hshift) + d;
#pragma unroll
            for (int i = 0; i < 16; ++i) dst[(size_t)crow(i, hh) << hshift] = acc[mi][ni][i];
          }
        }
      }
      continue;
    }
#pragma unroll
    for (int mi = 0; mi < 2; ++mi) {
#pragma unroll
      for (int ni = 0; ni < 2; ++ni) {
        const int c = wc * 64 + ni * 32 + cl;
        const int tok = tokmap(c);
        const int fl = (f0 & 511) + wr * 64 + mi * 32 + 4 * hh;
        float v[16];
#pragma unroll
        for (int i = 0; i < 16; ++i) v[i] = acc[mi][ni][i];
        if (do_rope) {
          const int pos = (tok - 4096) & 4095;
          const int axis = mi == 0 ? (pos >> 6) : (pos & 63);
#pragma unroll
          for (int i = 0; i < 8; ++i) {
            const float2 cssn = ROPE[axis * 16 + crow(i, hh)];
            const float x1 = v[i], x2 = v[i + 8];
            v[i] = x1 * cssn.x - x2 * cssn.y;
            v[i + 8] = x2 * cssn.x + x1 * cssn.y;
          }
        }
        if (do_scale) {
#pragma unroll
          for (int i = 0; i < 16; ++i) v[i] *= QSCALE;
        }
        if (do_silu) {
#pragma unroll
          for (int i = 0; i < 16; ++i) v[i] = silu_f(v[i]);
        }
        if (tr_v || tr_z) {
          size_t base;
          int fstride;
          if (!sample) {
            const int b = tok >> 8, t = tok & 255;
            base = (size_t)(b * 512) * 256 + t; fstride = 256;
          } else {
            const int bs = (tok - 4096) >> 12, pos = (tok - 4096) & 4095;
            if (tr_v) { base = (size_t)CTX_T + (size_t)(bs * 512) * 4096 + pos; }
            else { base = (size_t)CTX_T + (size_t)(bs * 512) * 4096 + (pos & 63) * 64 + (pos >> 6); }
            fstride = 4096;
          }
#pragma unroll
          for (int i = 0; i < 16; ++i) {
            const int f = fl + (i & 3) + 8 * (i >> 2);
            segp[base + (size_t)f * fstride] = f2bf(v[i]);
          }
        } else {
#pragma unroll
          for (int g = 0; g < 4; g += 2) {
            store_pair16(segp + (size_t)tok * 512 + (fl - 4 * hh) + 8 * g, make_uint2(pk2(v[4 * g], v[4 * g + 1]), pk2(v[4 * g + 2], v[4 * g + 3])),
                         make_uint2(pk2(v[4 * g + 4], v[4 * g + 5]), pk2(v[4 * g + 6], v[4 * g + 7])), hh);
          }
        }
        if (cache_out) {
          const int b = tok >> 8, t = tok & 255;
#pragma unroll
          for (int g = 0; g < 4; ++g) {
            const int f = fl + 8 * g;
            const int hd = f >> hshift, d = f & ((1 << hshift) - 1);
            const int nh = 512 >> hshift;
            float* dst = cache_out + ((size_t)((b * 2 + l) * nh + hd) * 256 + t) * (1 << hshift) + d;
            *(float4*)dst = make_float4(v[4 * g], v[4 * g + 1], v[4 * g + 2], v[4 * g + 3]);
          }
        }
      }
    }
  }
}

constexpr int KS_LD = 136;
constexpr int VS_LD = 72;
DI void diff_block(const Params& p, int l, bool sample, int b, int h, int q64, u16* smem) {
  const int tid = threadIdx.x, lane = tid & 63, wid = tid >> 6, cl = lane & 31, hh = lane >> 5;
  const int qt = wid & 1, m = wid >> 1;
  const int tok = (sample ? 4096 + b * 4096 : b * 256) + q64 * 64 + qt * 32 + cl;
  u16* qseg = Pseg(p, 7);
  bf16x8 qf[4];
  {
    const u16* qp = qseg + (size_t)tok * 512 + h * 128 + m * 64 + hh * 8;
#pragma unroll
    for (int s = 0; s < 4; ++s) qf[s] = *(const bf16x8*)(qp + s * 16);
  }
  f32x16 O[4];
#pragma unroll
  for (int mt = 0; mt < 4; ++mt) zero16(O[mt]);
  float mr = -INFINITY, ls = 0.f;
  const int nt = sample ? 68 : 4, ncache = sample ? 4 : 0;
  const u16* kc = (const u16*)(p.ws + OFF_CDK) + (size_t)(((b * 2 + l) * 4 + h) * 256) * 128;
  const u16* vc = (const u16*)(p.ws + OFF_CDVT) + (size_t)(((b * 2 + l) * 4 + h) * 128) * 256;
  const u16* kl = Pseg(p, 8) + (size_t)(sample ? 4096 + b * 4096 : b * 256) * 512 + h * 128;
  const int vldl = sample ? 4096 : 256;
  const u16* vl = Pseg(p, 9) + (sample ? (size_t)CTX_T + (size_t)(b * 512 + h * 128) * 4096 : (size_t)(b * 512 + h * 128) * 256);
  u16* Ks = smem;
  u16* Vs = smem + 2 * 64 * KS_LD;
  uint4 rk[4], rv[4];
  unsigned ko[4], vo[4];
  auto set_offsets = [&](int kld, int vld) {
#pragma unroll
    for (int i = 0; i < 4; ++i) {
      const int e = tid + 256 * i;
      ko[i] = (unsigned)((e >> 4) * kld + (e & 15) * 8);
      vo[i] = (unsigned)((e >> 3) * vld + (e & 7) * 8);
    }
  };
  if (ncache) set_offsets(128, 256); else set_offsets(512, vldl);
  auto issue = [&](int t) {
    const u16 *kb, *vb;
    if (t < ncache) { kb = kc + (size_t)t * 64 * 128; vb = vc + t * 64; }
    else { kb = kl + (size_t)(t - ncache) * 64 * 512; vb = vl + (t - ncache) * 64; }
    if (ncache && t == ncache) set_offsets(512, vldl);
#pragma unroll
    for (int i = 0; i < 4; ++i) {
      rk[i] = *(const uint4*)(kb + ko[i]);
      rv[i] = *(const uint4*)(vb + vo[i]);
    }
  };
  auto stage = [&](int buf) {
#pragma unroll
    for (int i = 0; i < 4; ++i) {
      const int e = tid + 256 * i;
      *(uint4*)(Ks + buf * 64 * KS_LD + (e >> 4) * KS_LD + (e & 15) * 8) = rk[i];
      *(uint4*)(Vs + buf * 128 * VS_LD + (e >> 3) * VS_LD + (e & 7) * 8) = rv[i];
    }
  };
  issue(0);
  stage(0);
  __syncthreads();
  for (int t = 0; t < nt; ++t) {
    const int cur = t & 1;
    const bool more = t + 1 < nt;
    if (more) issue(t + 1);
    const u16* Kc = Ks + cur * 64 * KS_LD + cl * KS_LD + m * 64 + hh * 8;
    const u16* Vc = Vs + cur * 128 * VS_LD + cl * VS_LD + 8 * hh;
    f32x16 st0, st1;
    zero16(st0);
    zero16(st1);
#pragma unroll
    for (int s = 0; s < 4; ++s) {
      const bf16x8 a0 = *(const bf16x8*)(Kc + s * 16);
      const bf16x8 a1 = *(const bf16x8*)(Kc + 32 * KS_LD + s * 16);
      st0 = MFMA32(a0, qf[s], st0);
      st1 = MFMA32(a1, qf[s], st1);
    }
    float mx = fmax_nc(st0[0], st1[0]);
#pragma unroll
    for (int i = 1; i < 16; ++i) mx = fmax_nc(mx, fmax_nc(st0[i], st1[i]));
    mx = fmax_nc(mx, __shfl_xor(mx, 32));
    if (__any(mx > mr + 8.f)) {
      const float mnew = fmax_nc(mr, mx);
      const float alpha = ex2(mr - mnew);
      ls *= alpha;
#pragma unroll
      for (int mt = 0; mt < 4; ++mt)
#pragma unroll
        for (int i = 0; i < 16; ++i) O[mt][i] *= alpha;
      mr = mnew;
    }
    float sum = 0.f;
#pragma unroll
    for (int i = 0; i < 16; ++i) {
      st0[i] = ex2(st0[i] - mr);
      st1[i] = ex2(st1[i] - mr);
      sum += st0[i] + st1[i];
    }
    ls += sum;
    bf16x8 pf[4];
    pf[0] = pack8(st0, 0);
    pf[1] = pack8(st0, 1);
    pf[2] = pack8(st1, 0);
    pf[3] = pack8(st1, 1);
#pragma unroll
    for (int mt = 0; mt < 4; ++mt) {
#pragma unroll
      for (int s4 = 0; s4 < 4; ++s4) {
        const bf16x8 a = *(const bf16x8*)(Vc + mt * 32 * VS_LD + s4 * 16);
        O[mt] = MFMA32(a, pf[s4], O[mt]);
      }
    }
    if (more) stage(cur ^ 1);
    __syncthreads();
  }
  float* Cb = (float*)smem;
  const float lam = ((const float*)(p.ws + OFF_LAM))[l];
  const float lam_init = 0.8f - 0.6f * expf(-0.3f * (float)l);
  const float ltot = ls + __shfl_xor(ls, 32);
  if (m == 1) {
    const float sc = lam / ltot;
#pragma unroll
    for (int mt = 0; mt < 4; ++mt)
#pragma unroll
      for (int i = 0; i < 16; ++i) Cb[(qt * 64 + mt * 16 + i) * 64 + lane] = O[mt][i] * sc;
  }
  __syncthreads();
  if (m == 0) {
    const float i0 = 1.f / ltot;
    float ss = 0.f;
#pragma unroll
    for (int mt = 0; mt < 4; ++mt)
#pragma unroll
      for (int i = 0; i < 16; ++i) {
        const float o = O[mt][i] * i0 - Cb[(qt * 64 + mt * 16 + i) * 64 + lane];
        O[mt][i] = o;
        ss += o * o;
      }
    ss += __shfl_xor(ss, 32);
    const float rs = rsqrtf(ss * (1.f / 128.f) + 1e-6f) * (1.f - lam_init);
    const u16* zseg = Pseg(p, 10);
    const float* sg = p.subln_g + l * 128;
#pragma unroll
    for (int mt = 0; mt < 4; ++mt)
#pragma unroll
      for (int g = 0; g < 4; g += 2) {
        const int dvb = mt * 32 + 8 * g;
        const float4 ga = *(const float4*)(sg + dvb + 4 * hh), gb = *(const float4*)(sg + dvb + 8 + 4 * hh);
        uint2 za, zb;
        load_pair16(zseg + (size_t)tok * 512 + h * 128 + dvb, hh, za, zb);
        const float o0 = O[mt][4 * g + 0] * rs * ga.x * bf2f(za.x & 0xffffu);
        const float o1 = O[mt][4 * g + 1] * rs * ga.y * bf2f(za.x >> 16);
        const float o2 = O[mt][4 * g + 2] * rs * ga.z * bf2f(za.y & 0xffffu);
        const float o3 = O[mt][4 * g + 3] * rs * ga.w * bf2f(za.y >> 16);
        const float o4 = O[mt][4 * g + 4] * rs * gb.x * bf2f(zb.x & 0xffffu);
        const float o5 = O[mt][4 * g + 5] * rs * gb.y * bf2f(zb.x >> 16);
        const float o6 = O[mt][4 * g + 6] * rs * gb.z * bf2f(zb.y & 0xffffu);
        const float o7 = O[mt][4 * g + 7] * rs * gb.w * bf2f(zb.y >> 16);
        store_pair16(qseg + (size_t)tok * 512 + h * 128 + dvb, make_uint2(pk2(o0, o1), pk2(o2, o3)), make_uint2(pk2(o4, o5), pk2(o6, o7)), hh);
      }
  }
  __syncthreads();
}

constexpr int NA_LD = 72;
DI void na_block(const Params& p, int l, bool sample, int b, int h, int item, u16* smem) {
  const int tid = threadIdx.x, lane = tid & 63, wid = tid >> 6, cl = lane & 31, hh = lane >> 5;
  const int row = sample ? 2 * item + (wid >> 1) : 0;
  const int c0 = sample ? (wid & 1) * 32 : 0;
  const int tok = sample ? 4096 + b * 4096 + 64 * row + c0 + cl : b * 256 + item * 128 + wid * 32 + cl;
  u16* qseg = Pseg(p, 0);
  bf16x8 qf[4];
  {
    const u16* qp = qseg + (size_t)tok * 512 + h * 64 + hh * 8;
#pragma unroll
    for (int s = 0; s < 4; ++s) qf[s] = *(const bf16x8*)(qp + s * 16);
  }
  u16* Ks = smem;
  u16* Vs = smem + 2 * 64 * NA_LD;
  float* bt = (float*)(smem + 4 * 64 * NA_LD);
  if (sample) {
    const float* rp = p.na_rpb + (size_t)(l * 8 + h) * 465;
    for (int i = tid; i < 465; i += 256) bt[i] = rp[i] * LOG2E;
  }
  f32x16 O[2];
  zero16(O[0]);
  zero16(O[1]);
  float mr = -INFINITY, ls = 0.f;
  const u16 *kc, *vc;
  int kldc;
  if (sample) {
    kc = (const u16*)(p.ws + OFF_CNK) + (size_t)(((b * 2 + l) * 8 + h) * 256) * 64;
    vc = (const u16*)(p.ws + OFF_CNVT) + (size_t)(((b * 2 + l) * 8 + h) * 64) * 256;
    kldc = 64;
  } else {
    kc = Pseg(p, 1) + (size_t)(b * 256) * 512 + h * 64;
    vc = Pseg(p, 2) + (size_t)(b * 512 + h * 64) * 256;
    kldc = 512;
  }
  const u16* kl = Pseg(p, 1) + (size_t)(4096 + b * 4096) * 512 + h * 64;
  const u16* vl = Pseg(p, 2) + (size_t)CTX_T + (size_t)(b * 512 + h * 64) * 4096;
  const int rsA = min(max(2 * item - 4, 0), 56), rsB = min(max(2 * item - 3, 0), 56);
  const int nt = sample ? 4 + (rsB + 8 - rsA) : 4;
  const int rsw = min(max(row - 4, 0), 56);
  const int qc = c0 + cl, cs = min(max(qc - 8, 0), 48);
  uint4 rk0, rk1, rv0, rv1;
  const int e0 = tid, e1 = tid + 256;
#define NA_ISSUE(T)                                                                          \
  {                                                                                          \
    const u16 *ks_, *vs_;                                                                    \
    int kld_, vld_, key0_;                                                                   \
    if ((T) < 4) { ks_ = kc; kld_ = kldc; vs_ = vc; vld_ = 256; key0_ = (T) * 64; }          \
    else { ks_ = kl; kld_ = 512; vs_ = vl; vld_ = 4096; key0_ = (rsA + (T) - 4) * 64; }      \
    rk0 = *(const uint4*)(ks_ + (size_t)(key0_ + (e0 >> 3)) * kld_ + (e0 & 7) * 8);          \
    rk1 = *(const uint4*)(ks_ + (size_t)(key0_ + (e1 >> 3)) * kld_ + (e1 & 7) * 8);          \
    rv0 = *(const uint4*)(vs_ + (size_t)(e0 >> 3) * vld_ + key0_ + (e0 & 7) * 8);            \
    rv1 = *(const uint4*)(vs_ + (size_t)(e1 >> 3) * vld_ + key0_ + (e1 & 7) * 8);            \
  }
#define NA_STAGE1(E, RK, RV, BUF)                                                            \
  {                                                                                          \
    *(uint4*)(Ks + (BUF) * 64 * NA_LD + ((E) >> 3) * NA_LD + ((E) & 7) * 8) = RK;            \
    *(uint4*)(Vs + (BUF) * 64 * NA_LD + ((E) >> 3) * NA_LD + ((E) & 7) * 8) = RV;            \
  }
#define NA_STAGE(BUF) { NA_STAGE1(e0, rk0, rv0, BUF) NA_STAGE1(e1, rk1, rv1, BUF) }
  NA_ISSUE(0)
  NA_STAGE(0)
  __syncthreads();
  for (int t = 0; t < nt; ++t) {
    const int cur = t & 1;
    const bool more = t + 1 < nt;
    if (more) NA_ISSUE(t + 1)
    const int kr = rsA + t - 4;
    const bool local = t >= 4;
    const bool active = !local || (kr >= rsw && kr < rsw + 8);
    if (active) {
      const u16* Kc = Ks + cur * 64 * NA_LD + cl * NA_LD + hh * 8;
      const u16* Vc = Vs + cur * 64 * NA_LD + cl * NA_LD + 8 * hh;
      f32x16 st0, st1;
      zero16(st0);
      zero16(st1);
#pragma unroll
      for (int s = 0; s < 4; ++s) {
        const bf16x8 a0 = *(const bf16x8*)(Kc + s * 16);
        const bf16x8 a1 = *(const bf16x8*)(Kc + 32 * NA_LD + s * 16);
        st0 = MFMA32(a0, qf[s], st0);
        st1 = MFMA32(a1, qf[s], st1);
      }
      if (local) {
        const float* br = bt + (kr - row + 7) * 31;
#pragma unroll
        for (int i = 0; i < 16; ++i) {
          const int k0 = crow(i, hh), k1 = 32 + k0;
          const bool ok0 = (k0 >= cs) && (k0 < cs + 16), ok1 = (k1 >= cs) && (k1 < cs + 16);
          const int i0 = min(max(k0 - qc + 15, 0), 30), i1 = min(max(k1 - qc + 15, 0), 30);
          st0[i] = ok0 ? st0[i] + br[i0] : -INFINITY;
          st1[i] = ok1 ? st1[i] + br[i1] : -INFINITY;
        }
      }
      float mx = fmaxf(st0[0], st1[0]);
#pragma unroll
      for (int i = 1; i < 16; ++i) mx = fmaxf(mx, fmaxf(st0[i], st1[i]));
      mx = fmaxf(mx, __shfl_xor(mx, 32));
      if (__any(mx > mr + 8.f)) {
        const float mnew = fmaxf(mr, mx);
        const float alpha = ex2(mr - mnew);
        ls *= alpha;
#pragma unroll
        for (int i = 0; i < 16; ++i) {
          O[0][i] *= alpha;
          O[1][i] *= alpha;
        }
        mr = mnew;
      }
      float sum = 0.f;
#pragma unroll
      for (int i = 0; i < 16; ++i) {
        st0[i] = ex2(st0[i] - mr);
        st1[i] = ex2(st1[i] - mr);
        sum += st0[i] + st1[i];
      }
      ls += sum;
      bf16x8 pf[4];
      pf[0] = pack8(st0, 0);
      pf[1] = pack8(st0, 1);
      pf[2] = pack8(st1, 0);
      pf[3] = pack8(st1, 1);
#pragma unroll
      for (int mt = 0; mt < 2; ++mt)
#pragma unroll
        for (int s4 = 0; s4 < 4; ++s4) {
          const bf16x8 a = *(const bf16x8*)(Vc + mt * 32 * NA_LD + s4 * 16);
          O[mt] = MFMA32(a, pf[s4], O[mt]);
        }
    }
    if (more) NA_STAGE(cur ^ 1)
    __syncthreads();
  }
#undef NA_ISSUE
#undef NA_STAGE1
#undef NA_STAGE
  const float linv = 1.f / (ls + __shfl_xor(ls, 32));
  const u16* zseg = Pseg(p, 3);
  uint2 zz[2][4];
#pragma unroll
  for (int mt = 0; mt < 2; ++mt)
#pragma unroll
    for (int g = 0; g < 4; g += 2) load_pair16(zseg + (size_t)tok * 512 + h * 64 + mt * 32 + 8 * g, hh, zz[mt][g], zz[mt][g + 1]);
#pragma unroll
  for (int mt = 0; mt < 2; ++mt)
#pragma unroll
    for (int g = 0; g < 4; g += 2) {
      const int dv = mt * 32 + 8 * g;
      const float o0 = O[mt][4 * g + 0] * linv * bf2f(zz[mt][g].x & 0xffffu);
      const float o1 = O[mt][4 * g + 1] * linv * bf2f(zz[mt][g].x >> 16);
      const float o2 = O[mt][4 * g + 2] * linv * bf2f(zz[mt][g].y & 0xffffu);
      const float o3 = O[mt][4 * g + 3] * linv * bf2f(zz[mt][g].y >> 16);
      const float o4 = O[mt][4 * g + 4] * linv * bf2f(zz[mt][g + 1].x & 0xffffu);
      const float o5 = O[mt][4 * g + 5] * linv * bf2f(zz[mt][g + 1].x >> 16);
      const float o6 = O[mt][4 * g + 6] * linv * bf2f(zz[mt][g + 1].y & 0xffffu);
      const float o7 = O[mt][4 * g + 7] * linv * bf2f(zz[mt][g + 1].y >> 16);
      store_pair16(qseg + (size_t)tok * 512 + h * 64 + dv, make_uint2(pk2(o0, o1), pk2(o2, o3)), make_uint2(pk2(o4, o5), pk2(o6, o7)), hh);
    }
}

template <int NT>
DI void frag_gemm_t(const u16* a0, const u16* a1, const u16* bp  , int b_nt_stride, int halfsteps, f32x16 (&acc)[NT]) {
  for (int half = 0; half < 2; ++half) {
    const u16* ap = half ? a1 : a0;
    const u16* bq = bp + half * halfsteps * 16;
    for (int s = 0; s < halfsteps; ++s) {
      const bf16x8 av = *(const bf16x8*)(ap + s * 16);
#pragma unroll
      for (int nt = 0; nt < NT; ++nt) {
        const bf16x8 bv = *(const bf16x8*)(bq + (size_t)nt * b_nt_stride + s * 16);
        acc[nt] = MFMA32(av, bv, acc[nt]);
      }
    }
  }
}

DI void fnet_stage1_item(const Params& p, int b, int ct) {
  const int lane = threadIdx.x & 63, cl = lane & 31, hh = lane >> 5;
  const int ch = ct >> 1, qh = ct & 1;
  const u16* D1 = (const u16*)(p.ws + OFF_D1);
  const size_t zoff = (size_t)CTX_T + ((size_t)(b * 512 + ch) * 64 + qh * 32 + cl) * 64 + hh * 8;
  f32x16 acc[4];
#pragma unroll
  for (int nt = 0; nt < 4; ++nt) zero16(acc[nt]);
  frag_gemm_t<4>(Pseg(p, 4) + zoff, Pseg(p, 5) + zoff, D1 + (size_t)cl * 128 + hh * 8, 32 * 128, 4, acc);
  const float2* TW = (const float2*)(p.ws + OFF_TW);
  u16* AT = (u16*)(p.ws + OFF_AT);
#pragma unroll
  for (int j = 0; j < 2; ++j) {
    const int k1 = 32 * j + cl;
    u16* dre = AT + ((size_t)((b * 2 + 0) * 512 + ch)) * 4096 + k1 * 64 + qh * 32;
    u16* dim = AT + ((size_t)((b * 2 + 1) * 512 + ch)) * 4096 + k1 * 64 + qh * 32;
#pragma unroll
    for (int g = 0; g < 4; g += 2) {
      float re2[8], im2[8];
#pragma unroll
      for (int e = 0; e < 8; ++e) {
        const int i = 4 * g + e;
        const float2 tw = TW[(qh * 32 + crow(i, hh)) * 64 + k1];
        const float re = acc[j][i], im = acc[j + 2][i];
        re2[e] = re * tw.x + im * tw.y;
        im2[e] = im * tw.x - re * tw.y;
      }
      store_pair16(dre + 8 * g, make_uint2(pk2(re2[0], re2[1]), pk2(re2[2], re2[3])), make_uint2(pk2(re2[4], re2[5]), pk2(re2[6], re2[7])), hh);
      store_pair16(dim + 8 * g, make_uint2(pk2(im2[0], im2[1]), pk2(im2[2], im2[3])), make_uint2(pk2(im2[4], im2[5]), pk2(im2[6], im2[7])), hh);
    }
  }
}

DI void fnet_ctx_item(const Params& p, int b, int cht, int rh) {
  const int lane = threadIdx.x & 63, cl = lane & 31, hh = lane >> 5;
  const u16* D256 = (const u16*)(p.ws + OFF_D256);
  const size_t zoff = (size_t)(b * 512 + cht * 32 + cl) * 256 + hh * 8;
  f32x16 acc[4];
#pragma unroll
  for (int nt = 0; nt < 4; ++nt) zero16(acc[nt]);
  frag_gemm_t<4>(Pseg(p, 4) + zoff, Pseg(p, 5) + zoff, D256 + (size_t)(rh * 128 + cl) * 512 + hh * 8, 32 * 512, 16, acc);
  u16* F = (u16*)(p.ws + OFF_F);
  const float sc = 0.00552427172801990f;
#pragma unroll
  for (int nt = 0; nt < 4; ++nt) {
    const int k = rh * 128 + nt * 32 + cl;
    u16* dst = F + (size_t)(b * 256 + k) * 512 + cht * 32;
#pragma unroll
    for (int g = 0; g < 4; g += 2)
      store_pair16(dst + 8 * g, make_uint2(pk2(acc[nt][4 * g] * sc, acc[nt][4 * g + 1] * sc), pk2(acc[nt][4 * g + 2] * sc, acc[nt][4 * g + 3] * sc)),
                   make_uint2(pk2(acc[nt][4 * g + 4] * sc, acc[nt][4 * g + 5] * sc), pk2(acc[nt][4 * g + 6] * sc, acc[nt][4 * g + 7] * sc)), hh);
  }
}

DI void fnet_stage2_item(const Params& p, int b, int k1, int cht) {
  const int lane = threadIdx.x & 63, cl = lane & 31, hh = lane >> 5;
  const int ch = cht * 32 + cl;
  const u16* D2 = (const u16*)(p.ws + OFF_D2);
  const u16* AT = (const u16*)(p.ws + OFF_AT);
  f32x16 acc[2];
  zero16(acc[0]);
  zero16(acc[1]);
  frag_gemm_t<2>(AT + ((size_t)((b * 2 + 0) * 512 + ch)) * 4096 + k1 * 64 + hh * 8, AT + ((size_t)((b * 2 + 1) * 512 + ch)) * 4096 + k1 * 64 + hh * 8,
                 D2 + (size_t)cl * 128 + hh * 8, 32 * 128, 4, acc);
  u16* F = (u16*)(p.ws + OFF_F);
  const float sc = 0.00138106793200498f;
#pragma unroll
  for (int nt = 0; nt < 2; ++nt) {
    const int k2 = nt * 32 + cl;
    u16* dst = F + (size_t)(4096 + b * 4096 + k1 + 64 * k2) * 512 + cht * 32;
#pragma unroll
    for (int g = 0; g < 4; g += 2)
      store_pair16(dst + 8 * g, make_uint2(pk2(acc[nt][4 * g] * sc, acc[nt][4 * g + 1] * sc), pk2(acc[nt][4 * g + 2] * sc, acc[nt][4 * g + 3] * sc)),
                   make_uint2(pk2(acc[nt][4 * g + 4] * sc, acc[nt][4 * g + 5] * sc), pk2(acc[nt][4 * g + 6] * sc, acc[nt][4 * g + 7] * sc)), hh);
  }
}

DI void phase_mixA(const Params& p, int l, u16* smem) {
  const int gw = blockIdx.x * 4 + (threadIdx.x >> 6), nw = gridDim.x * 4;
  for (int it = blockIdx.x; it < 768; it += gridDim.x) {
    const bool smp = it < 512;
    const int j = smp ? it : it - 512;
    const int b = smp ? ((j & 7) >> 2) : (j >> 4), h = smp ? (j & 3) : ((j >> 2) & 3), q64 = smp ? (j >> 3) : (j & 3);
    diff_block(p, l, smp, b, h, q64, smem);
  }
  for (int it = gridDim.x - 1 - blockIdx.x; it < 768; it += gridDim.x) {
    const bool smp = it < 512;
    const int j = smp ? it : it - 512;
    const int bh = smp ? ((j & 7) * 2 + (j >> 8)) : 0;
    const int b = smp ? (bh >> 3) : (j >> 4), h = smp ? (bh & 7) : ((j >> 1) & 7), qi = smp ? ((j >> 3) & 31) : (j & 1);
    na_block(p, l, smp, b, h, qi, smem);
  }
  for (int it = nw - 1 - gw; it < 2560; it += nw) {
    if (it < 2048) fnet_stage1_item(p, it >> 10, it & 1023);
    else { const int j = it - 2048; fnet_ctx_item(p, j >> 5, (j >> 1) & 15, j & 1); }
  }
}

DI void phase_mixB(const Params& p) {
  const int gw = blockIdx.x * 4 + (threadIdx.x >> 6), nw = gridDim.x * 4;
  for (int it = gw; it < 2048; it += nw) fnet_stage2_item(p, it >> 10, (it >> 4) & 63, it & 15);
}

DI void phase_fnetw(const Params& p, int l, u16* smem) {
  const int tid = threadIdx.x, lane = tid & 63, wid = tid >> 6, wr = wid >> 1, wc = wid & 1, cl = lane & 31, hh = lane >> 5;
  const u16* wf = (const u16*)(p.ws + OFF_WF) + (size_t)l * 512 * 512;
  const u16* F = (const u16*)(p.ws + OFF_F);
  u16* zs = Pseg(p, 6);
  int ft, tt;
  for (int it = 0; xcd_map(it, 4, 96, 1, ft, tt); ++it) {
    const int f0 = ft * 128, t0 = tt * 128;
    f32x16 acc[2][2];
#pragma unroll
    for (int a = 0; a < 2; ++a)
#pragma unroll
      for (int b = 0; b < 2; ++b) zero16(acc[a][b]);
    gemm_core<2>([&](int r) { return wf + (size_t)(f0 + r) * 512; }, [&](int c) { return F + (size_t)(t0 + c) * 512; }, 512, acc, smem);
#pragma unroll
    for (int ni = 0; ni < 2; ++ni) {
      const int tok = t0 + wc * 64 + ni * 32 + cl;
      uint2 zz[2][4];
#pragma unroll
      for (int mi = 0; mi < 2; ++mi)
#pragma unroll
        for (int g = 0; g < 4; g += 2) load_pair16(zs + (size_t)tok * 512 + f0 + wr * 64 + mi * 32 + 8 * g, hh, zz[mi][g], zz[mi][g + 1]);
#pragma unroll
      for (int mi = 0; mi < 2; ++mi)
#pragma unroll
        for (int g = 0; g < 4; g += 2) {
          const int f = f0 + wr * 64 + mi * 32 + 8 * g;
          const float o0 = acc[mi][ni][4 * g + 0] * bf2f(zz[mi][g].x & 0xffffu), o1 = acc[mi][ni][4 * g + 1] * bf2f(zz[mi][g].x >> 16);
          const float o2 = acc[mi][ni][4 * g + 2] * bf2f(zz[mi][g].y & 0xffffu), o3 = acc[mi][ni][4 * g + 3] * bf2f(zz[mi][g].y >> 16);
          const float o4 = acc[mi][ni][4 * g + 4] * bf2f(zz[mi][g + 1].x & 0xffffu), o5 = acc[mi][ni][4 * g + 5] * bf2f(zz[mi][g + 1].x >> 16);
          const float o6 = acc[mi][ni][4 * g + 6] * bf2f(zz[mi][g + 1].y & 0xffffu), o7 = acc[mi][ni][4 * g + 7] * bf2f(zz[mi][g + 1].y >> 16);
          store_pair16(zs + (size_t)tok * 512 + f, make_uint2(pk2(o0, o1), pk2(o2, o3)), make_uint2(pk2(o4, o5), pk2(o6, o7)), hh);
        }
    }
  }
}

DI int sig_seg(int b, int half) { return b == 0 ? 1 + half : (b == 1 ? 8 + half : (half ? 10 : 3)); }
DI void phase_gates(const Params& p, int l, u16* smem) {
  const int tid = threadIdx.x, lane = tid & 63, wid = tid >> 6, wr = wid >> 1, wc = wid & 1, cl = lane & 31, hh = lane >> 5;
  const u16* wt = WTl(p, l) + (size_t)5632 * 1024;
  const u16* H = (const u16*)(p.ws + OFF_H);
  int ft, tt;
  for (int it = 0; xcd_map(it, 24, 96, 4, ft, tt); ++it) {
    const int n0 = ft * 128, t0 = tt * 128;
    f32x16 acc[2][2];
#pragma unroll
    for (int a = 0; a < 2; ++a)
#pragma unroll
      for (int b = 0; b < 2; ++b) zero16(acc[a][b]);
    gemm_core<2>([&](int r) { return wt + (size_t)(n0 + r) * 1024; }, [&](int c) { return H + (size_t)(t0 + c) * 1024; }, 1024, acc, smem);
    const int bb = n0 >> 10, f = n0 & 1023;
    u16* dstseg = Pseg(p, sig_seg(bb, f >> 9));
#pragma unroll
    for (int ni = 0; ni < 2; ++ni) {
      const int tok = t0 + wc * 64 + ni * 32 + cl;
#pragma unroll
      for (int mi = 0; mi < 2; ++mi)
#pragma unroll
        for (int g = 0; g < 4; g += 2) {
          const int fc = (f & 511) + wr * 64 + mi * 32 + 8 * g;
          store_pair16(dstseg + (size_t)tok * 512 + fc,
                       make_uint2(pk2(sigmoid_f(acc[mi][ni][4 * g]), sigmoid_f(acc[mi][ni][4 * g + 1])),
                                  pk2(sigmoid_f(acc[mi][ni][4 * g + 2]), sigmoid_f(acc[mi][ni][4 * g + 3]))),
                       make_uint2(pk2(sigmoid_f(acc[mi][ni][4 * g + 4]), sigmoid_f(acc[mi][ni][4 * g + 5])),
                                  pk2(sigmoid_f(acc[mi][ni][4 * g + 6]), sigmoid_f(acc[mi][ni][4 * g + 7]))), hh);
        }
    }
  }
}

DI void phase_merge(const Params& p, int l, u16* smem) {
  const int tid = threadIdx.x, lane = tid & 63, wid = tid >> 6, wr = wid >> 1, wc = wid & 1, cl = lane & 31, hh = lane >> 5;
  const u16* WB = (const u16*)(p.ws + OFF_WB) + (size_t)l * 3 * 1024 * 512;
  u16* Y = Pseg(p, 4);
  int ft, tt;
  for (int it = 0; xcd_map(it, 8, 96, 2, ft, tt); ++it) {
    const int f0 = ft * 128, t0 = tt * 128;
    f32x16 y[2][2];
#pragma unroll
    for (int a = 0; a < 2; ++a)
#pragma unroll
      for (int b = 0; b < 2; ++b) zero16(y[a][b]);
#pragma unroll 1
    for (int b = 0; b < 3; ++b) {
      f32x16 au[2][2];
#pragma unroll
      for (int a = 0; a < 2; ++a)
#pragma unroll
        for (int c = 0; c < 2; ++c) zero16(au[a][c]);
      const u16* U = Pseg(p, b == 0 ? 0 : (b == 1 ? 6 : 7));
      const u16* wb = WB + (size_t)b * 1024 * 512;
      gemm_core<2, false>([&](int r) { return wb + (size_t)(f0 + r) * 512; }, [&](int c) { return U + (size_t)(t0 + c) * 512; }, 512, au, smem);
      const u16* sg = Pseg(p, sig_seg(b, f0 >> 9));
#pragma unroll
      for (int ni = 0; ni < 2; ++ni) {
        const int tok = t0 + wc * 64 + ni * 32 + cl;
#pragma unroll
        for (int mi = 0; mi < 2; ++mi)
#pragma unroll
          for (int g = 0; g < 4; g += 2) {
            const int fc = (f0 & 511) + wr * 64 + mi * 32 + 8 * g;
            uint2 za, zb;
            load_pair16(sg + (size_t)tok * 512 + fc, hh, za, zb);
            y[mi][ni][4 * g + 0] += au[mi][ni][4 * g + 0] * bf2f(za.x & 0xffffu);
            y[mi][ni][4 * g + 1] += au[mi][ni][4 * g + 1] * bf2f(za.x >> 16);
            y[mi][ni][4 * g + 2] += au[mi][ni][4 * g + 2] * bf2f(za.y & 0xffffu);
            y[mi][ni][4 * g + 3] += au[mi][ni][4 * g + 3] * bf2f(za.y >> 16);
            y[mi][ni][4 * g + 4] += au[mi][ni][4 * g + 4] * bf2f(zb.x & 0xffffu);
            y[mi][ni][4 * g + 5] += au[mi][ni][4 * g + 5] * bf2f(zb.x >> 16);
            y[mi][ni][4 * g + 6] += au[mi][ni][4 * g + 6] * bf2f(zb.y & 0xffffu);
            y[mi][ni][4 * g + 7] += au[mi][ni][4 * g + 7] * bf2f(zb.y >> 16);
          }
      }
    }
#pragma unroll
    for (int ni = 0; ni < 2; ++ni) {
      const int tok = t0 + wc * 64 + ni * 32 + cl;
#pragma unroll
      for (int mi = 0; mi < 2; ++mi)
#pragma unroll
        for (int g = 0; g < 4; g += 2) {
          const int f = f0 + wr * 64 + mi * 32 + 8 * g;
          store_pair16(Y + (size_t)tok * 1024 + f, make_uint2(pk2(y[mi][ni][4 * g], y[mi][ni][4 * g + 1]), pk2(y[mi][ni][4 * g + 2], y[mi][ni][4 * g + 3])),
                       make_uint2(pk2(y[mi][ni][4 * g + 4], y[mi][ni][4 * g + 5]), pk2(y[mi][ni][4 * g + 6], y[mi][ni][4 * g + 7])), hh);
        }
    }
  }
}

DI void phase_wout(const Params& p, int l, u16* smem) {
  const int tid = threadIdx.x, lane = tid & 63, wid = tid >> 6, wr = wid >> 1, wc = wid & 1, cl = lane & 31, hh = lane >> 5;
  const u16* wo = (const u16*)(p.ws + OFF_WO) + (size_t)l * 1024 * 1024;
  const u16* Y = Pseg(p, 4);
  const float* MOD = (const float*)(p.ws + OFF_MOD);
  int ft, tt;
  for (int it = 0; xcd_map(it, 8, 96, 2, ft, tt); ++it) {
    const int f0 = ft * 128, t0 = tt * 128;
    f32x16 acc[2][2];
#pragma unroll
    for (int a = 0; a < 2; ++a)
#pragma unroll
      for (int b = 0; b < 2; ++b) zero16(acc[a][b]);
    gemm_core<2>([&](int r) { return wo + (size_t)(f0 + r) * 1024; }, [&](int c) { return Y + (size_t)(t0 + c) * 1024; }, 1024, acc, smem);
#pragma unroll
    for (int ni = 0; ni < 2; ++ni) {
      const int tok = t0 + wc * 64 + ni * 32 + cl;
      const float* xr = xin(p, l, tok);
      const float* gate = MOD + (l * 3 + vec_of(tok)) * 3072 + 2048;
      float* orow = p.out + (size_t)tok * 1024;
      float4 xv[2][4], gv[2][4];
#pragma unroll
      for (int mi = 0; mi < 2; ++mi)
#pragma unroll
        for (int g = 0; g < 4; ++g) {
          const int f = f0 + wr * 64 + mi * 32 + 4 * hh + 8 * g;
          xv[mi][g] = *(const float4*)(xr + f);
          gv[mi][g] = *(const float4*)(gate + f);
        }
#pragma unroll
      for (int mi = 0; mi < 2; ++mi)
#pragma unroll
        for (int g = 0; g < 4; ++g) {
          const int f = f0 + wr * 64 + mi * 32 + 4 * hh + 8 * g;
          float4 o;
          o.x = xv[mi][g].x + gv[mi][g].x * acc[mi][ni][4 * g + 0];
          o.y = xv[mi][g].y + gv[mi][g].y * acc[mi][ni][4 * g + 1];
          o.z = xv[mi][g].z + gv[mi][g].z * acc[mi][ni][4 * g + 2];
          o.w = xv[mi][g].w + gv[mi][g].w * acc[mi][ni][4 * g + 3];
          *(float4*)(orow + f) = o;
        }
    }
  }
}

DI void phase_final(const Params& p) {
  const int lane = threadIdx.x & 63, wid = threadIdx.x >> 6;
  for (int row = (blockIdx.x * 4 + wid) * 2; row < 12288; row += gridDim.x * 8) {
    float* x0 = p.out + (size_t)row * 1024;
    float* x1 = x0 + 1024;
    float4 xa[4], xb[4], g[4];
#pragma unroll
    for (int j = 0; j < 4; ++j) {
      xa[j] = *(const float4*)(x0 + j * 256 + lane * 4);
      xb[j] = *(const float4*)(x1 + j * 256 + lane * 4);
      g[j] = *(const float4*)(p.final_g + j * 256 + lane * 4);
    }
    float sa = 0.f, sb = 0.f;
#pragma unroll
    for (int j = 0; j < 4; ++j) {
      sa += xa[j].x * xa[j].x + xa[j].y * xa[j].y + xa[j].z * xa[j].z + xa[j].w * xa[j].w;
      sb += xb[j].x * xb[j].x + xb[j].y * xb[j].y + xb[j].z * xb[j].z + xb[j].w * xb[j].w;
    }
#pragma unroll
    for (int o = 32; o; o >>= 1) {
      sa += __shfl_xor(sa, o);
      sb += __shfl_xor(sb, o);
    }
    const float ra = rsqrtf(sa * (1.f / 1024.f) + 1e-6f), rb = rsqrtf(sb * (1.f / 1024.f) + 1e-6f);
#pragma unroll
    for (int j = 0; j < 4; ++j) {
      const int col = j * 256 + lane * 4;
      *(float4*)(x0 + col) = make_float4(xa[j].x * ra * g[j].x, xa[j].y * ra * g[j].y, xa[j].z * ra * g[j].z, xa[j].w * ra * g[j].w);
      *(float4*)(x1 + col) = make_float4(xb[j].x * rb * g[j].x, xb[j].y * rb * g[j].y, xb[j].z * rb * g[j].z, xb[j].w * rb * g[j].w);
    }
  }
}

#define XB_TMO      128
#define XB_XCNT(j)  (256  + 64 * (j))
#define XB_XSUB(j)  (1280 + 64 * (j))
#define XB_XGEN(j)  (2304 + 64 * (j))
#define XB_TOP      3328
#define XB_TOPGEN   3392
#define XB_SPIN_CAP (1u << 18)
#define LAS __attribute__((address_space(3)))
DI unsigned xb_ld(unsigned* p) { return __hip_atomic_load(p, __ATOMIC_RELAXED, __HIP_MEMORY_SCOPE_AGENT); }
DI unsigned xb_add(unsigned* p, unsigned v) { return __hip_atomic_fetch_add(p, v, __ATOMIC_RELAXED, __HIP_MEMORY_SCOPE_AGENT); }
DI unsigned xb_xcc_id() { return (unsigned)__builtin_amdgcn_s_getreg((3 << 11) | 20) & 0xFu; }
#define XB_SPIN(cond, bar) do { unsigned _sp = 0; while (cond) { __builtin_amdgcn_s_sleep(1); \
    if ((++_sp & 255u) == 0u) { if (xb_ld(&(bar)[XB_TMO])) break; if (_sp > XB_SPIN_CAP) { atomicAdd(&(bar)[XB_TMO], 1u); break; } } } } while (0)
struct XcdBarrier {
  unsigned* bar;
  unsigned x;
  volatile LAS unsigned* st;
};
DI XcdBarrier xcd_barrier_post(unsigned* bar, volatile LAS unsigned* st) {
  XcdBarrier b;
  b.bar = bar;
  b.x = xb_xcc_id();
  b.st = st;
  if (threadIdx.x == 0) (void)xb_add(&bar[XB_XCNT(b.x)], 1u);
  return b;
}
DI void xcd_barrier_complete(unsigned* bar, unsigned x, unsigned& nloc, unsigned& nx) {
  const unsigned G = gridDim.x * gridDim.y * gridDim.z;
  unsigned sum, cnt, mine, sp = 0u;
  for (;;) {
    sum = 0u; cnt = 0u; mine = 0u;
#pragma unroll
    for (unsigned j = 0; j < 16; ++j) {
      const unsigned c = xb_ld(&bar[XB_XCNT(j)]);
      sum += c;
      cnt += (c > 0u) ? 1u : 0u;
      mine = (j == x) ? c : mine;
    }
    if (sum == G) break;
    __builtin_amdgcn_s_sleep(1);
    if ((++sp & 255u) == 0u) {
      if (xb_ld(&bar[XB_TMO])) break;
      if (sp > XB_SPIN_CAP) { atomicAdd(&bar[XB_TMO], 1u); break; }
    }
  }
  nloc = mine > 0u ? mine : 1u;
  nx = cnt > 0u ? cnt : 1u;
}
DI void xcd_barrier(const XcdBarrier& b) {
  asm volatile("s_waitcnt vmcnt(0)" ::: "memory");
  __syncthreads();
  if (threadIdx.x == 0) {
    unsigned* bar = b.bar;
    __builtin_amdgcn_s_waitcnt(0);
    unsigned nloc = b.st[0], nx = b.st[1];
    if (nloc == 0u) {
      xcd_barrier_complete(bar, b.x, nloc, nx);
      b.st[0] = nloc;
      b.st[1] = nx;
    }
    const unsigned old = xb_add(&bar[XB_XSUB(b.x)], 1u);
    const unsigned gen = old / nloc;
    if (old + 1u == (gen + 1u) * nloc) {
      __builtin_amdgcn_fence(__ATOMIC_RELEASE, "agent");
      asm volatile("s_waitcnt vmcnt(0)" ::: "memory");
      const unsigned og = xb_add(&bar[XB_TOP], 1u);
      const unsigned tg = og / nx;
      if (og + 1u == (tg + 1u) * nx) xb_add(&bar[XB_TOPGEN], 1u);
      else XB_SPIN(xb_ld(&bar[XB_TOPGEN]) == tg, bar);
      __builtin_amdgcn_fence(__ATOMIC_ACQUIRE, "agent");
      xb_add(&bar[XB_XGEN(b.x)], 1u);
      asm volatile("s_waitcnt vmcnt(0)" ::: "memory");
    } else {
      XB_SPIN(xb_ld(&bar[XB_XGEN(b.x)]) == gen, bar);
      __builtin_amdgcn_fence(__ATOMIC_ACQUIRE, "agent");
      asm volatile("s_waitcnt vmcnt(0)" ::: "memory");
    }
  }
  __syncthreads();
}

constexpr int SMEM_BYTES = (2 * 128 * LDT + 2 * 128 * LDT) * 2;

__global__ void __launch_bounds__(256, 2) fwd_megakernel(Params p, int ph_lo, int ph_hi, int use_cg) {
  __shared__ __attribute__((aligned(16))) char smem[SMEM_BYTES];
  __shared__ uint4 xb_words;
  cg::grid_group grid = cg::this_grid();
  if (threadIdx.x == 0) xb_words = make_uint4(0u, 0u, 0u, 0u);
  __syncthreads();
  XcdBarrier xb = xcd_barrier_post((unsigned*)(p.ws + OFF_BAR), (volatile LAS unsigned*)&xb_words);
#define GRID_SYNC() do { if (use_cg) grid.sync(); else xcd_barrier(xb); } while (0)
#define RUN_PHASE(PH, CALL)                       \
  if (ph_lo <= (PH) && (PH) < ph_hi) {            \
    CALL;                                         \
    if ((PH) + 1 < ph_hi) GRID_SYNC();            \
  }
#define RUN_LAYER(L)                                                                           \
  RUN_PHASE(1 + 7 * (L) + 0, { phase_h(p, (L)); if ((L) == 0) phase_prep(p, smem, 2); })        \
  RUN_PHASE(1 + 7 * (L) + 1, phase_win(p, (L), (u16*)smem))                                    \
  RUN_PHASE(1 + 7 * (L) + 2, phase_mixA(p, (L), (u16*)smem))                                   \
  RUN_PHASE(1 + 7 * (L) + 3, { phase_mixB(p); phase_gates(p, (L), (u16*)smem); })              \
  RUN_PHASE(1 + 7 * (L) + 4, phase_fnetw(p, (L), (u16*)smem))                                  \
  RUN_PHASE(1 + 7 * (L) + 5, phase_merge(p, (L), (u16*)smem))                                  \
  RUN_PHASE(1 + 7 * (L) + 6, phase_wout(p, (L), (u16*)smem))
  RUN_PHASE(0, phase_prep(p, smem, 1))
  RUN_LAYER(0)
  RUN_LAYER(1)
  RUN_PHASE(15, phase_final(p))
}

extern "C" void kernel_launch(void* const* d_in, const int* in_sizes, int n_in, void* d_out, int out_size, void* d_ws, size_t ws_size,
                              hipStream_t stream) {
  static int grid_blocks = 0;
  if (!grid_blocks) {
    int dev = 0, cus = 0, per_cu = 0;
    hipGetDevice(&dev);
    hipDeviceGetAttribute(&cus, hipDeviceAttributeMultiprocessorCount, dev);
    hipOccupancyMaxActiveBlocksPerMultiprocessor(&per_cu, fwd_megakernel, 256, 0);
    if (per_cu > 2) per_cu = 2;
    if (per_cu < 1) per_cu = 1;
    grid_blocks = cus * per_cu;
  }
  Params p{};
  const float** pp = (const float**)&p;
  for (int i = 0; i < 22; ++i) pp[i] = (const float*)d_in[i];
  p.out = (float*)d_out;
  p.ws = (char*)d_ws;
  int lo = 0, hi = 16, use_cg = 0;
  hipMemsetAsync((char*)d_ws + OFF_BAR, 0, BAR_BYTES, stream);
  void* args[] = {&p, &lo, &hi, &use_cg};
  hipError_t e = hipLaunchCooperativeKernel((void*)fwd_megakernel, dim3(grid_blocks), dim3(256), args, 0, stream);
  if (e != hipSuccess) fprintf(stderr, "cooperative launch failed: %s (grid %d)\n", hipGetErrorString(e), grid_blocks);
}
```

```cpp
#include <hip/hip_runtime.h>
#include <hip/hip_cooperative_groups.h>
#include <cstdio>
namespace cg = cooperative_groups;

typedef unsigned short u16;
using bf16x8 = __attribute__((ext_vector_type(8))) short;
using s16x4  = __attribute__((ext_vector_type(4))) short;
using f32x16 = __attribute__((ext_vector_type(16))) float;
typedef __attribute__((ext_vector_type(2))) float f32x2_t;
typedef __attribute__((ext_vector_type(2))) __bf16 bf16x2_t;

#define DI __device__ __forceinline__
#define MFMA32(a, b, c) __builtin_amdgcn_mfma_f32_32x32x16_bf16((a), (b), (c), 0, 0, 0)

struct Params {
  const float *x_prompt, *x_sample, *cna_k, *cna_v, *cdk, *cdv, *c, *c_ctx, *norm_g, *w_mod, *b_mod, *w_in, *na_rpb, *fnet_w,
      *lq1, *lk1, *lq2, *lk2, *subln_g, *w_branch, *w_out, *final_g;
  float* out;
  char* ws;
};

constexpr size_t SEGE = 12288ull * 512ull;
constexpr size_t SEGB = SEGE * 2;
constexpr size_t OFF_P = 0;
constexpr size_t OFF_WT = OFF_P + 11 * SEGB;
constexpr size_t WT_L = 8704ull * 1024ull;
constexpr size_t OFF_WB = OFF_WT + 2 * WT_L * 2;
constexpr size_t OFF_WO = OFF_WB + 2ull * 3 * 1024 * 512 * 2;
constexpr size_t OFF_WF = OFF_WO + 2ull * 1024 * 1024 * 2;
constexpr size_t OFF_H = OFF_WF + 2ull * 512 * 512 * 2;
constexpr size_t OFF_F = OFF_H + 12288ull * 1024 * 2;
constexpr size_t OFF_AT = OFF_F + SEGB;
constexpr size_t OFF_CNK = OFF_AT + 2ull * 2 * 512 * 4096 * 2;
constexpr size_t OFF_CNVT = OFF_CNK + 524288ull * 2;
constexpr size_t OFF_CDK = OFF_CNVT + 524288ull * 2;
constexpr size_t OFF_CDVT = OFF_CDK + 524288ull * 2;
constexpr size_t OFF_D1 = OFF_CDVT + 524288ull * 2;
constexpr size_t OFF_D2 = OFF_D1 + 128 * 128 * 2;
constexpr size_t OFF_D256 = OFF_D2 + 64 * 128 * 2;
constexpr size_t OFF_TW = OFF_D256 + 256 * 512 * 2;
constexpr size_t OFF_ROPE = OFF_TW + 4096 * 8;
constexpr size_t OFF_MOD = OFF_ROPE + 1024 * 8;
constexpr size_t OFF_LAM = OFF_MOD + 2 * 3 * 3072 * 4;
constexpr size_t OFF_BAR = OFF_LAM + 256;
constexpr size_t BAR_BYTES = 3456 * 4;
constexpr size_t WS_END = OFF_BAR + BAR_BYTES;
static_assert(WS_END <= 268435456ull, "workspace too large");

constexpr int CTX_T = 2097152;
constexpr float QSCALE = 0.125f * 1.44269504088896f;
constexpr float LOG2E = 1.44269504088896f;

constexpr size_t OUT_NAK = 12582912, OUT_NAV = 16777216, OUT_DK = 20971520, OUT_DV = 25165824;

DI unsigned pk2(float a, float b) {
  bf16x2_t q = __builtin_convertvector((f32x2_t){a, b}, bf16x2_t);
  return __builtin_bit_cast(unsigned, q);
}
DI u16 f2bf(float a) { return (u16)(pk2(a, 0.f) & 0xffffu); }
DI float bf2f(unsigned v) { return __uint_as_float(v << 16); }
DI int crow(int i, int hh) { return (i & 3) + 8 * (i >> 2) + 4 * hh; }
DI float silu_f(float x) { return x / (1.f + __expf(-x)); }
DI float sigmoid_f(float x) { return 1.f / (1.f + __expf(-x)); }
DI float ex2(float x) { return __builtin_amdgcn_exp2f(x); }
DI float fmax_nc(float a, float b) { return __builtin_amdgcn_fmed3f(a, b, __builtin_inff()); }

DI u16* Pseg(const Params& p, int s) { return (u16*)(p.ws + OFF_P) + (size_t)s * SEGE; }
DI u16* WTl(const Params& p, int l) { return (u16*)(p.ws + OFF_WT) + (size_t)l * WT_L; }
DI const float* xin(const Params& p, int l, int tok) {
  if (l == 0) return tok < 4096 ? p.x_prompt + (size_t)tok * 1024 : p.x_sample + (size_t)(tok - 4096) * 1024;
  return p.out + (size_t)tok * 1024;
}
DI int vec_of(int tok) { return tok < 4096 ? 0 : 1 + ((tok - 4096) >> 12); }

DI void zero16(f32x16& a) {
#pragma unroll
  for (int i = 0; i < 16; ++i) a[i] = 0.f;
}
DI bf16x8 pack8(const f32x16& x, int s) {
  unsigned a = pk2(x[8 * s], x[8 * s + 1]), b = pk2(x[8 * s + 2], x[8 * s + 3]), c = pk2(x[8 * s + 4], x[8 * s + 5]),
           d = pk2(x[8 * s + 6], x[8 * s + 7]);
  uint4 u = make_uint4(a, b, c, d);
  return __builtin_bit_cast(bf16x8, u);
}

DI void store_pair16(u16* p_g  , uint2 a, uint2 b, int hh) {
  const auto r0 = __builtin_amdgcn_permlane32_swap(a.x, b.x, false, false);
  const auto r1 = __builtin_amdgcn_permlane32_swap(a.y, b.y, false, false);
  *(uint4*)(p_g + 8 * hh) = make_uint4(r0[0], r1[0], r0[1], r1[1]);
}

DI void load_pair16(const u16* p_g  , int hh, uint2& a, uint2& b) {
  const uint4 L = *(const uint4*)(p_g + 8 * hh);
  const auto r0 = __builtin_amdgcn_permlane32_swap(L.x, L.z, false, false);
  const auto r1 = __builtin_amdgcn_permlane32_swap(L.y, L.w, false, false);
  a = make_uint2(r0[0], r1[0]);
  b = make_uint2(r0[1], r1[1]);
}

constexpr int LDT = 72;
template <int NI, bool IGLP = true>
DI void g_compute(const u16* Ac, const u16* Bc, f32x16 (&acc)[2][NI]) {
  if (IGLP) __builtin_amdgcn_iglp_opt(1);
#pragma unroll
  for (int s = 0; s < 4; ++s) {
    const bf16x8 a0 = *(const bf16x8*)(Ac + s * 16);
    const bf16x8 a1 = *(const bf16x8*)(Ac + 32 * LDT + s * 16);
    bf16x8 b[NI];
#pragma unroll
    for (int ni = 0; ni < NI; ++ni) b[ni] = *(const bf16x8*)(Bc + ni * 32 * LDT + s * 16);
#pragma unroll
    for (int ni = 0; ni < NI; ++ni) {
      acc[0][ni] = MFMA32(a0, b[ni], acc[0][ni]);
      acc[1][ni] = MFMA32(a1, b[ni], acc[1][ni]);
    }
  }
}
template <int NI, bool PF2 = true, class FA, class FB>
DI void gemm_core(FA arow, FB brow, int K, f32x16 (&acc)[2][NI], u16* smem) {
  u16* As = smem;
  u16* Bs = smem + 2 * 128 * LDT;
  const int tid = threadIdx.x, lane = tid & 63, wid = tid >> 6, wr = wid >> 1, wc = wid & 1;
  const int lrow = tid >> 3, lchk = (tid & 7) * 8;
  const int cl = lane & 31, hh = lane >> 5;
  const u16* pa0 = arow(lrow) + lchk;
  const u16* pa1 = arow(lrow + 32) + lchk;
  const u16* pa2 = arow(lrow + 64) + lchk;
  const u16* pa3 = arow(lrow + 96) + lchk;
  const u16* pb0 = brow(lrow) + lchk;
  const u16* pb1 = brow(lrow + 32) + lchk;
  const u16* pb2 = NI == 2 ? brow(lrow + 64) + lchk : pb0;
  const u16* pb3 = NI == 2 ? brow(lrow + 96) + lchk : pb0;
  const int nk = K >> 6;
  const u16* Ac0 = As + (wr * 64 + cl) * LDT + hh * 8;
  const u16* Bc0 = Bs + (wc * 32 * NI + cl) * LDT + hh * 8;
  u16* Aw = As + lrow * LDT + lchk;
  u16* Bw = Bs + lrow * LDT + lchk;
  uint4 x0, x1, x2, x3, x4, x5, x6, x7;
  uint4 y0, y1, y2, y3, y4, y5, y6, y7;
#define GL(P, OFF) (*(const uint4*)((P) + (OFF)))
#define GLOAD0(OFF)                                                                   \
  x0 = GL(pa0, OFF); x1 = GL(pa1, OFF); x2 = GL(pa2, OFF); x3 = GL(pa3, OFF);          \
  x4 = GL(pb0, OFF); x5 = GL(pb1, OFF);                                                \
  if (NI == 2) { x6 = GL(pb2, OFF); x7 = GL(pb3, OFF); }
#define GLOAD1(OFF)                                                                   \
  y0 = GL(pa0, OFF); y1 = GL(pa1, OFF); y2 = GL(pa2, OFF); y3 = GL(pa3, OFF);          \
  y4 = GL(pb0, OFF); y5 = GL(pb1, OFF);                                                \
  if (NI == 2) { y6 = GL(pb2, OFF); y7 = GL(pb3, OFF); }
#define GS(P, V) (*(uint4*)(P) = (V))
#define GSTORE0(AB, BB)                                                               \
  GS((AB), x0); GS((AB) + 32 * LDT, x1); GS((AB) + 64 * LDT, x2); GS((AB) + 96 * LDT, x3); \
  GS((BB), x4); GS((BB) + 32 * LDT, x5);                                               \
  if (NI == 2) { GS((BB) + 64 * LDT, x6); GS((BB) + 96 * LDT, x7); }
#define GSTORE1(AB, BB)                                                               \
  GS((AB), y0); GS((AB) + 32 * LDT, y1); GS((AB) + 64 * LDT, y2); GS((AB) + 96 * LDT, y3); \
  GS((BB), y4); GS((BB) + 32 * LDT, y5);                                               \
  if (NI == 2) { GS((BB) + 64 * LDT, y6); GS((BB) + 96 * LDT, y7); }
  if (!PF2) {
    GLOAD0(0)
    GSTORE0(Aw, Bw)
    __syncthreads();
    for (int kt = 0; kt < nk; ++kt) {
      const int cur = kt & 1;
      const bool more = kt + 1 < nk;
      if (more) { GLOAD0((kt + 1) * 64) }
      g_compute<NI, false>(Ac0 + cur * 128 * LDT, Bc0 + cur * 64 * NI * LDT, acc);
      if (more) { GSTORE0(Aw + (cur ^ 1) * 128 * LDT, Bw + (cur ^ 1) * 64 * NI * LDT) }
      __syncthreads();
    }
    return;
  }
  GLOAD0(0)
  GSTORE0(Aw, Bw)
  GLOAD1(64)
  __syncthreads();
  for (int kt = 0; kt < nk; kt += 2) {
    const int k2 = (kt + 2) * 64;
    const bool m2 = kt + 2 < nk;
    if (m2) { GLOAD0(k2) }
    __builtin_amdgcn_sched_barrier(0);
    g_compute<NI>(Ac0, Bc0, acc);
    GSTORE1(Aw + 128 * LDT, Bw + 64 * NI * LDT)
    __syncthreads();
    if (m2) { GLOAD1(k2 + 64) }
    __builtin_amdgcn_sched_barrier(0);
    g_compute<NI>(Ac0 + 128 * LDT, Bc0 + 64 * NI * LDT, acc);
    if (m2) { GSTORE0(Aw, Bw) }
    __syncthreads();
  }
#undef GL
#undef GS
#undef GLOAD0
#undef GLOAD1
#undef GSTORE0
#undef GSTORE1
}

DI bool xcd_map(int it, int NF, int NT, int GXF, int& ft, int& tt) {
  const int x = blockIdx.x & 7, j = blockIdx.x >> 3, nb = gridDim.x >> 3;
  const int GXT = 8 / GXF, Fx = NF / GXF, Tx = NT / GXT;
  const int idx = j + it * nb;
  if (idx >= Fx * Tx) return false;
  ft = (x % GXF) * Fx + idx % Fx;
  tt = (x / GXF) * Tx + idx / Fx;
  return true;
}

DI void phase_prep(const Params& p, char* smem, int part) {
  const int tid = threadIdx.x;
  u16* WB = (u16*)(p.ws + OFF_WB);
  u16* WO = (u16*)(p.ws + OFF_WO);
  u16* WF = (u16*)(p.ws + OFF_WF);
  if (part & 2) {
    float* t = (float*)smem;
    for (int job = blockIdx.x; job < 5248; job += gridDim.x) {
      const float* src;
      u16* dst;
      int ldsrc, lddst, k0, ns0, nd0;
      int j = job;
      if (j < 3840) {
        const int l = j / 1920;
        j %= 1920;
        const int nt = j >> 4, kt = j & 15;
        const int nd = nt < 32 ? nt * 64 : 3072 + (nt - 32) * 64;
        const int nsrc = nt < 32 ? nd : nd - 512;
        src = p.w_in + (size_t)l * 1024 * 8192; ldsrc = 8192; dst = WTl(p, l); lddst = 1024; k0 = kt * 64; ns0 = nsrc; nd0 = nd;
      } else if (j < 4608) {
        j -= 3840;
        const int lb = j >> 7;
        j &= 127;
        const int nt = j >> 3, kt = j & 7;
        src = p.w_branch + (size_t)lb * 512 * 1024; ldsrc = 1024; dst = WB + (size_t)lb * 1024 * 512; lddst = 512; k0 = kt * 64; ns0 = nd0 = nt * 64;
      } else if (j < 5120) {
        j -= 4608;
        const int l = j >> 8;
        j &= 255;
        const int nt = j >> 4, kt = j & 15;
        src = p.w_out + (size_t)l * 1024 * 1024; ldsrc = 1024; dst = WO + (size_t)l * 1024 * 1024; lddst = 1024; k0 = kt * 64; ns0 = nd0 = nt * 64;
      } else {
        j -= 5120;
        const int l = j >> 6;
        j &= 63;
        const int nt = j >> 3, kt = j & 7;
        src = p.fnet_w + (size_t)l * 512 * 512; ldsrc = 512; dst = WF + (size_t)l * 512 * 512; lddst = 512; k0 = kt * 64; ns0 = nd0 = nt * 64;
      }
#pragma unroll
      for (int i = 0; i < 4; ++i) {
        const int row = (tid >> 4) + 16 * i, c4 = (tid & 15) * 4;
        const float4 v = *(const float4*)(src + (size_t)(k0 + row) * ldsrc + ns0 + c4);
        t[row * 65 + c4 + 0] = v.x; t[row * 65 + c4 + 1] = v.y; t[row * 65 + c4 + 2] = v.z; t[row * 65 + c4 + 3] = v.w;
      }
      __syncthreads();
#pragma unroll
      for (int i = 0; i < 2; ++i) {
        const int n = (tid >> 3) + 32 * i, kk = (tid & 7) * 8;
        uint4 o;
        o.x = pk2(t[(kk + 0) * 65 + n], t[(kk + 1) * 65 + n]);
        o.y = pk2(t[(kk + 2) * 65 + n], t[(kk + 3) * 65 + n]);
        o.z = pk2(t[(kk + 4) * 65 + n], t[(kk + 5) * 65 + n]);
        o.w = pk2(t[(kk + 6) * 65 + n], t[(kk + 7) * 65 + n]);
        *(uint4*)(dst + (size_t)(nd0 + n) * lddst + k0 + kk) = o;
      }
      __syncthreads();
    }
  }
  if (part & 2) {
    float* tt = (float*)smem;
    float* ctab = tt + 128 * 32;
    for (int job = blockIdx.x; job < 256; job += gridDim.x) {
      const int l = job >> 7, g = (job >> 5) & 3, k0 = (job & 31) * 32;
      if (tid < 128) ctab[tid] = cospif((float)tid * (1.f / 64.f));
#pragma unroll
      for (int i = 0; i < 4; ++i) {
        const int idx = tid + 256 * i, row = idx >> 5, c4 = (idx & 31) * 4;
        const float4 v = *(const float4*)(p.w_in + ((size_t)l * 1024 + k0 + row) * 8192 + 2048 + g * 128 + c4);
        tt[(c4 + 0) * 32 + row] = v.x; tt[(c4 + 1) * 32 + row] = v.y; tt[(c4 + 2) * 32 + row] = v.z; tt[(c4 + 3) * 32 + row] = v.w;
      }
      __syncthreads();
      const int m = tid & 127, cs = tid >> 7;
      float acc[32];
#pragma unroll
      for (int k = 0; k < 32; ++k) acc[k] = 0.f;
      for (int c = 0; c < 128; ++c) {
        const float tr = ctab[(c * m - cs * 32) & 127];
        const float4* rp = (const float4*)(tt + c * 32);
#pragma unroll
        for (int k4 = 0; k4 < 8; ++k4) {
          const float4 w = rp[k4];
          acc[4 * k4 + 0] += w.x * tr; acc[4 * k4 + 1] += w.y * tr; acc[4 * k4 + 2] += w.z * tr; acc[4 * k4 + 3] += w.w * tr;
        }
      }
      u16* dst = WTl(p, l) + (size_t)(2048 + cs * 512 + g * 128 + m) * 1024 + k0;
#pragma unroll
      for (int k8 = 0; k8 < 4; ++k8) {
        uint4 o;
        o.x = pk2(acc[8 * k8 + 0], acc[8 * k8 + 1]); o.y = pk2(acc[8 * k8 + 2], acc[8 * k8 + 3]);
        o.z = pk2(acc[8 * k8 + 4], acc[8 * k8 + 5]); o.w = pk2(acc[8 * k8 + 6], acc[8 * k8 + 7]);
        *(uint4*)(dst + 8 * k8) = o;
      }
      __syncthreads();
    }
  }
  if (part & 1) {
    const int gt = blockIdx.x * 256 + tid, gs = gridDim.x * 256;
    u16* CNK = (u16*)(p.ws + OFF_CNK);
    u16* CNVT = (u16*)(p.ws + OFF_CNVT);
    u16* CDK = (u16*)(p.ws + OFF_CDK);
    u16* CDVT = (u16*)(p.ws + OFF_CDVT);
    for (int i = gt; i < 524288; i += gs) {
      CNK[i] = f2bf(p.cna_k[i]);
      CDK[i] = f2bf(p.cdk[i]);
      const int tp = i & 255, q4 = (tp >> 2) & 3;
      const int t = (tp & ~12) | ((q4 == 1 ? 2 : (q4 == 2 ? 1 : q4)) << 2);
      {
        const int blh = i >> 14, d = (i >> 8) & 63;
        CNVT[i] = f2bf(p.cna_v[(size_t)(blh * 256 + t) * 64 + d]);
      }
      {
        const int blh = i >> 15, d = (i >> 8) & 127;
        CDVT[i] = f2bf(p.cdv[(size_t)(blh * 256 + t) * 128 + d]);
      }
    }
    u16* D1 = (u16*)(p.ws + OFF_D1);
    u16* D2 = (u16*)(p.ws + OFF_D2);
    u16* D256 = (u16*)(p.ws + OFF_D256);
    float2* TW = (float2*)(p.ws + OFF_TW);
    float2* ROPE = (float2*)(p.ws + OFF_ROPE);
    float* LAM = (float*)(p.ws + OFF_LAM);
    for (int i = gt; i < 128 * 128; i += gs) {
      const int row = i >> 7, col = i & 127, k1 = row & 63, ri = row >> 6, cs = col >> 6, r = col & 63;
      const int a = (r * k1) & 63;
      const float c = cospif(a * (1.f / 32.f)), s = sinpif(a * (1.f / 32.f));
      const float v = ri == 0 ? (cs == 0 ? c : -s) : (cs == 0 ? -s : -c);
      D1[i] = f2bf(v);
    }
    for (int i = gt; i < 64 * 128; i += gs) {
      const int k2 = i >> 7, col = i & 127, ri = col >> 6, q = col & 63;
      const int a = (q * k2) & 63;
      D2[i] = f2bf(ri == 0 ? cospif(a * (1.f / 32.f)) : sinpif(a * (1.f / 32.f)));
    }
    for (int i = gt; i < 256 * 512; i += gs) {
      const int k = i >> 9, col = i & 511, cs = col >> 8, t = col & 255;
      const int a = (t * k) & 255;
      D256[i] = f2bf(cs == 0 ? cospif(a * (1.f / 128.f)) : -sinpif(a * (1.f / 128.f)));
    }
    for (int i = gt; i < 4096; i += gs) {
      const int q = i >> 6, k1 = i & 63;
      const float a = (float)(q * k1) * (1.f / 2048.f);
      TW[i] = make_float2(cospif(a), sinpif(a));
    }
    for (int i = gt; i < 1024; i += gs) {
      const int pos = i >> 4, fi = i & 15;
      const float inv = powf(10000.f, -(float)fi * (1.f / 16.f));
      const float ang = (float)pos * inv;
      ROPE[i] = make_float2(cosf(ang), sinf(ang));
    }
    if (gt < 2) {
      const int l = gt;
      float s1 = 0.f, s2 = 0.f;
      for (int d = 0; d < 64; ++d) {
        s1 += p.lq1[l * 64 + d] * p.lk1[l * 64 + d];
        s2 += p.lq2[l * 64 + d] * p.lk2[l * 64 + d];
      }
      const float lam_init = 0.8f - 0.6f * expf(-0.3f * (float)l);
      LAM[l] = expf(s1) - expf(s2) + lam_init;
    }
  }
  if (part & 1) {
    float* sc = (float*)smem;
    float* red = sc + 3072;
    float* MOD = (float*)(p.ws + OFF_MOD);
    if (blockIdx.x < 384) {
      for (int i = tid; i < 3072; i += 256) {
        const int v = i >> 10, k = i & 1023;
        const float cv = v == 0 ? p.c_ctx[k] : p.c[(v - 1) * 1024 + k];
        sc[i] = silu_f(cv);
      }
      __syncthreads();
      for (int job = blockIdx.x; job < 384; job += gridDim.x) {
        const int l = job / 192, n0 = (job % 192) * 16, n = tid & 15, kq = tid >> 4;
        float a0 = 0.f, a1 = 0.f, a2 = 0.f;
        const float* w = p.w_mod + ((size_t)l * 1024 + kq * 64) * 3072 + n0 + n;
#pragma unroll
        for (int kb = 0; kb < 64; kb += 16) {
          float wv[16];
#pragma unroll
          for (int u = 0; u < 16; ++u) wv[u] = w[(size_t)(kb + u) * 3072];
#pragma unroll
          for (int u = 0; u < 16; ++u) {
            const int k = kq * 64 + kb + u;
            a0 += sc[k] * wv[u];
            a1 += sc[1024 + k] * wv[u];
            a2 += sc[2048 + k] * wv[u];
          }
        }
        red[(kq * 3 + 0) * 16 + n] = a0; red[(kq * 3 + 1) * 16 + n] = a1; red[(kq * 3 + 2) * 16 + n] = a2;
        __syncthreads();
        if (tid < 48) {
          const int v = tid >> 4, nn = tid & 15;
          float sum = p.b_mod[l * 3072 + n0 + nn];
#pragma unroll
          for (int q = 0; q < 16; ++q) sum += red[(q * 3 + v) * 16 + nn];
          MOD[(l * 3 + v) * 3072 + n0 + nn] = sum;
        }
        __syncthreads();
      }
    }
  }
}

DI void phase_h(const Params& p, int l) {
  const int lane = threadIdx.x & 63, wid = threadIdx.x >> 6;
  const float* ng = p.norm_g + l * 1024;
  u16* H = (u16*)(p.ws + OFF_H);
  const float* MOD = (const float*)(p.ws + OFF_MOD);
  for (int row = (blockIdx.x * 4 + wid) * 2; row < 12288; row += gridDim.x * 8) {
    const float* x0 = xin(p, l, row);
    const float* x1 = xin(p, l, row + 1);
    const float* mod = MOD + (l * 3 + vec_of(row)) * 3072;
    float4 xa[4], xb[4], g[4], sh[4], sl[4];
#pragma unroll
    for (int j = 0; j < 4; ++j) {
      xa[j] = *(const float4*)(x0 + j * 256 + lane * 4);
      xb[j] = *(const float4*)(x1 + j * 256 + lane * 4);
    }
#pragma unroll
    for (int j = 0; j < 4; ++j) {
      const int col = j * 256 + lane * 4;
      g[j] = *(const float4*)(ng + col);
      sh[j] = *(const float4*)(mod + col);
      sl[j] = *(const float4*)(mod + 1024 + col);
    }
    float sa = 0.f, sb = 0.f;
#pragma unroll
    for (int j = 0; j < 4; ++j) {
      sa += xa[j].x * xa[j].x + xa[j].y * xa[j].y + xa[j].z * xa[j].z + xa[j].w * xa[j].w;
      sb += xb[j].x * xb[j].x + xb[j].y * xb[j].y + xb[j].z * xb[j].z + xb[j].w * xb[j].w;
    }
#pragma unroll
    for (int o = 32; o; o >>= 1) {
      sa += __shfl_xor(sa, o);
      sb += __shfl_xor(sb, o);
    }
    const float ra = rsqrtf(sa * (1.f / 1024.f) + 1e-6f), rb = rsqrtf(sb * (1.f / 1024.f) + 1e-6f);
#pragma unroll
    for (int j = 0; j < 4; ++j) {
      const int col = j * 256 + lane * 4;
      const float m0 = g[j].x * (1.f + sl[j].x), m1 = g[j].y * (1.f + sl[j].y), m2 = g[j].z * (1.f + sl[j].z), m3 = g[j].w * (1.f + sl[j].w);
      *(uint2*)(H + (size_t)row * 1024 + col) =
          make_uint2(pk2(xa[j].x * ra * m0 + sh[j].x, xa[j].y * ra * m1 + sh[j].y), pk2(xa[j].z * ra * m2 + sh[j].z, xa[j].w * ra * m3 + sh[j].w));
      *(uint2*)(H + (size_t)(row + 1) * 1024 + col) =
          make_uint2(pk2(xb[j].x * rb * m0 + sh[j].x, xb[j].y * rb * m1 + sh[j].y), pk2(xb[j].z * rb * m2 + sh[j].z, xb[j].w * rb * m3 + sh[j].w));
    }
  }
}

DI void phase_win(const Params& p, int l, u16* smem) {
  const int tid = threadIdx.x, lane = tid & 63, wid = tid >> 6, wr = wid >> 1, wc = wid & 1, cl = lane & 31, hh = lane >> 5;
  const u16* wt = WTl(p, l);
  const u16* H = (const u16*)(p.ws + OFF_H);
  const float2* ROPE = (const float2*)(p.ws + OFF_ROPE);
  int ft, tt;
  for (int it = 0; xcd_map(it, 44, 96, 4, ft, tt); ++it) {
    const int f0 = ft * 128, seg = f0 >> 9;
    const bool sample = tt >= 32;
    const bool zmap = sample && (seg == 4 || seg == 5);
    const int ts = tt - 32;
    auto tokmap = [&](int c) -> int {
      if (!zmap) return tt * 128 + c;
      return 4096 + (ts >> 5) * 4096 + 64 * (c & 63) + 2 * (ts & 31) + (c >> 6);
    };
    f32x16 acc[2][2];
#pragma unroll
    for (int a = 0; a < 2; ++a)
#pragma unroll
      for (int b = 0; b < 2; ++b) zero16(acc[a][b]);
    const bool tr = (seg == 2 || seg == 4 || seg == 5 || seg == 9);
    if (tr)
      gemm_core<2>([&](int c) { return H + (size_t)tokmap(c) * 1024; }, [&](int r) { return wt + (size_t)(f0 + r) * 1024; }, 1024, acc, smem);
    else
      gemm_core<2>([&](int r) { return wt + (size_t)(f0 + r) * 1024; }, [&](int c) { return H + (size_t)tokmap(c) * 1024; }, 1024, acc, smem);
    const bool do_scale = (seg == 0 || seg == 7);
    const bool do_silu = (seg == 3 || seg == 6 || seg == 10);
    const bool do_rope = sample && (seg == 7 || seg == 8);
    const bool tr_v = (seg == 2 || seg == 9);
    const bool tr_z = (seg == 4 || seg == 5);
    float* cache_out = nullptr;
    int hshift = 6;
    if (!sample) {
      if (seg == 1) cache_out = p.out + OUT_NAK;
      else if (seg == 2) cache_out = p.out + OUT_NAV;
      else if (seg == 8) { cache_out = p.out + OUT_DK; hshift = 7; }
      else if (seg == 9) { cache_out = p.out + OUT_DV; hshift = 7; }
    }
    u16* segp = Pseg(p, seg);
    if (tr) {
      const int tile0 = tt * 128;
#pragma unroll
      for (int mi = 0; mi < 2; ++mi) {
#pragma unroll
        for (int ni = 0; ni < 2; ++ni) {
          const int f = (f0 & 511) + wc * 64 + ni * 32 + cl;
          size_t rowbase;
          if (!sample) rowbase = (size_t)((tile0 >> 8) * 512 + f) * 256 + (tile0 & 255) + wr * 64 + mi * 32;
          else if (tr_v) rowbase = (size_t)CTX_T + (size_t)(((tile0 - 4096) >> 12) * 512 + f) * 4096 + ((tile0 - 4096) & 4095) + wr * 64 + mi * 32;
          else rowbase = (size_t)CTX_T + ((size_t)((ts >> 5) * 512 + f) * 64 + 2 * (ts & 31) + wr) * 64 + mi * 32;
#pragma unroll
          for (int g = 0; g < 4; g += 2) {
            const uint2 qa = make_uint2(pk2(acc[mi][ni][4 * g], acc[mi][ni][4 * g + 1]), pk2(acc[mi][ni][4 * g + 2], acc[mi][ni][4 * g + 3]));
            const uint2 qb = make_uint2(pk2(acc[mi][ni][4 * g + 4], acc[mi][ni][4 * g + 5]), pk2(acc[mi][ni][4 * g + 6], acc[mi][ni][4 * g + 7]));
            if (tr_v)
              *(uint4*)(segp + rowbase + 8 * g + 8 * hh) = make_uint4(qa.x, qa.y, qb.x, qb.y);
            else
              store_pair16(segp + rowbase + 8 * g, qa, qb, hh);
          }
          if (cache_out) {
            const int b = tile0 >> 8, hd = f >> hshift, d = f & ((1 << hshift) - 1), nh = 512 >> hshift;
            float* dst = cache_out + ((size_t)((b * 2 + l) * nh + hd) * 256 + (tile0 & 255) + wr * 64 + mi * 32) * (1 << hshift) + d;
#pragma unroll
            for (int i = 0; i < 16; ++i) dst[(size_t)crow(i, hh) << hshift] = acc[mi][ni][i];
          }
        }
      }
      continue;
    }
#pragma unroll
    for (int mi = 0; mi < 2; ++mi) {
#pragma unroll
      for (int ni = 0; ni < 2; ++ni) {
        const int c = wc * 64 + ni * 32 + cl;
        const int tok = tokmap(c);
        const int fl = (f0 & 511) + wr * 64 + mi * 32 + 4 * hh;
        float v[16];
#pragma unroll
        for (int i = 0; i < 16; ++i) v[i] = acc[mi][ni][i];
        if (do_rope) {
          const int pos = (tok - 4096) & 4095;
          const int axis = mi == 0 ? (pos >> 6) : (pos & 63);
#pragma unroll
          for (int i = 0; i < 8; ++i) {
            const float2 cssn = ROPE[axis * 16 + crow(i, hh)];
            const float x1 = v[i], x2 = v[i + 8];
            v[i] = x1 * cssn.x - x2 * cssn.y;
            v[i + 8] = x2 * cssn.x + x1 * cssn.y;
          }
        }
        if (do_scale) {
#pragma unroll
          for (int i = 0; i < 16; ++i) v[i] *= QSCALE;
        }
        if (do_silu) {
#pragma unroll
          for (int i = 0; i < 16; ++i) v[i] = silu_f(v[i]);
        }
        if (tr_v || tr_z) {
          size_t base;
          int fstride;
          if (!sample) {
            const int b = tok >> 8, t = tok & 255;
            base = (size_t)(b * 512) * 256 + t; fstride = 256;
          } else {
            const int bs = (tok - 4096) >> 12, pos = (tok - 4096) & 4095;
            if (tr_v) { base = (size_t)CTX_T + (size_t)(bs * 512) * 4096 + pos; }
            else { base = (size_t)CTX_T + (size_t)(bs * 512) * 4096 + (pos & 63) * 64 + (pos >> 6); }
            fstride = 4096;
          }
#pragma unroll
          for (int i = 0; i < 16; ++i) {
            const int f = fl + (i & 3) + 8 * (i >> 2);
            segp[base + (size_t)f * fstride] = f2bf(v[i]);
          }
        } else {
#pragma unroll
          for (int g = 0; g < 4; g += 2) {
            store_pair16(segp + (size_t)tok * 512 + (fl - 4 * hh) + 8 * g, make_uint2(pk2(v[4 * g], v[4 * g + 1]), pk2(v[4 * g + 2], v[4 * g + 3])),
                         make_uint2(pk2(v[4 * g + 4], v[4 * g + 5]), pk2(v[4 * g + 6], v[4 * g + 7])), hh);
          }
        }
        if (cache_out) {
          const int b = tok >> 8, t = tok & 255;
#pragma unroll
          for (int g = 0; g < 4; ++g) {
            const int f = fl + 8 * g;
            const int hd = f >> hshift, d = f & ((1 << hshift) - 1);
            const int nh = 512 >> hshift;
            float* dst = cache_out + ((size_t)((b * 2 + l) * nh + hd) * 256 + t) * (1 << hshift) + d;
            *(float4*)dst = make_float4(v[4 * g], v[4 * g + 1], v[4 * g + 2], v[4 * g + 3]);
          }
        }
      }
    }
  }
}

constexpr int KS_LD = 136;
constexpr int VS_LD = 72;
DI void diff_block(const Params& p, int l, bool sample, int b, int h, int q64, u16* smem) {
  const int tid = threadIdx.x, lane = tid & 63, wid = tid >> 6, cl = lane & 31, hh = lane >> 5;
  const int qt = wid & 1, m = wid >> 1;
  const int tok = (sample ? 4096 + b * 4096 : b * 256) + q64 * 64 + qt * 32 + cl;
  u16* qseg = Pseg(p, 7);
  bf16x8 qf[4];
  {
    const u16* qp = qseg + (size_t)tok * 512 + h * 128 + m * 64 + hh * 8;
#pragma unroll
    for (int s = 0; s < 4; ++s) qf[s] = *(const bf16x8*)(qp + s * 16);
  }
  f32x16 O[4];
#pragma unroll
  for (int mt = 0; mt < 4; ++mt) zero16(O[mt]);
  float mr = -INFINITY, ls = 0.f;
  const int nt = sample ? 68 : 4, ncache = sample ? 4 : 0;
  const u16* kc = (const u16*)(p.ws + OFF_CDK) + (size_t)(((b * 2 + l) * 4 + h) * 256) * 128;
  const u16* vc = (const u16*)(p.ws + OFF_CDVT) + (size_t)(((b * 2 + l) * 4 + h) * 128) * 256;
  const u16* kl = Pseg(p, 8) + (size_t)(sample ? 4096 + b * 4096 : b * 256) * 512 + h * 128;
  const int vldl = sample ? 4096 : 256;
  const u16* vl = Pseg(p, 9) + (sample ? (size_t)CTX_T + (size_t)(b * 512 + h * 128) * 4096 : (size_t)(b * 512 + h * 128) * 256);
  u16* Ks = smem;
  u16* Vs = smem + 2 * 64 * KS_LD;
  uint4 rk[4], rv[4];
  unsigned ko[4], vo[4];
  auto set_offsets = [&](int kld, int vld) {
#pragma unroll
    for (int i = 0; i < 4; ++i) {
      const int e = tid + 256 * i;
      ko[i] = (unsigned)((e >> 4) * kld + (e & 15) * 8);
      vo[i] = (unsigned)((e >> 3) * vld + (e & 7) * 8);
    }
  };
  if (ncache) set_offsets(128, 256); else set_offsets(512, vldl);
  auto issue = [&](int t) {
    const u16 *kb, *vb;
    if (t < ncache) { kb = kc + (size_t)t * 64 * 128; vb = vc + t * 64; }
    else { kb = kl + (size_t)(t - ncache) * 64 * 512; vb = vl + (t - ncache) * 64; }
    if (ncache && t == ncache) set_offsets(512, vldl);
#pragma unroll
    for (int i = 0; i < 4; ++i) {
      rk[i] = *(const uint4*)(kb + ko[i]);
      rv[i] = *(const uint4*)(vb + vo[i]);
    }
  };
  auto stage = [&](int buf) {
#pragma unroll
    for (int i = 0; i < 4; ++i) {
      const int e = tid + 256 * i;
      *(uint4*)(Ks + buf * 64 * KS_LD + (e >> 4) * KS_LD + (e & 15) * 8) = rk[i];
      *(uint4*)(Vs + buf * 128 * VS_LD + (e >> 3) * VS_LD + (e & 7) * 8) = rv[i];
    }
  };
  issue(0);
  stage(0);
  __syncthreads();
  for (int t = 0; t < nt; ++t) {
    const int cur = t & 1;
    const bool more = t + 1 < nt;
    if (more) issue(t + 1);
    const u16* Kc = Ks + cur * 64 * KS_LD + cl * KS_LD + m * 64 + hh * 8;
    const u16* Vc = Vs + cur * 128 * VS_LD + cl * VS_LD + 8 * hh;
    f32x16 st0, st1;
    zero16(st0);
    zero16(st1);
#pragma unroll
    for (int s = 0; s < 4; ++s) {
      const bf16x8 a0 = *(const bf16x8*)(Kc + s * 16);
      const bf16x8 a1 = *(const bf16x8*)(Kc + 32 * KS_LD + s * 16);
      st0 = MFMA32(a0, qf[s], st0);
      st1 = MFMA32(a1, qf[s], st1);
    }
    float mx = fmax_nc(st0[0], st1[0]);
#pragma unroll
    for (int i = 1; i < 16; ++i) mx = fmax_nc(mx, fmax_nc(st0[i], st1[i]));
    mx = fmax_nc(mx, __shfl_xor(mx, 32));
    if (__any(mx > mr + 8.f)) {
      const float mnew = fmax_nc(mr, mx);
      const float alpha = ex2(mr - mnew);
      ls *= alpha;
#pragma unroll
      for (int mt = 0; mt < 4; ++mt)
#pragma unroll
        for (int i = 0; i < 16; ++i) O[mt][i] *= alpha;
      mr = mnew;
    }
    float sum = 0.f;
#pragma unroll
    for (int i = 0; i < 16; ++i) {
      st0[i] = ex2(st0[i] - mr);
      st1[i] = ex2(st1[i] - mr);
      sum += st0[i] + st1[i];
    }
    ls += sum;
    bf16x8 pf[4];
    pf[0] = pack8(st0, 0);
    pf[1] = pack8(st0, 1);
    pf[2] = pack8(st1, 0);
    pf[3] = pack8(st1, 1);
#pragma unroll
    for (int mt = 0; mt < 4; ++mt) {
#pragma unroll
      for (int s4 = 0; s4 < 4; ++s4) {
        const bf16x8 a = *(const bf16x8*)(Vc + mt * 32 * VS_LD + s4 * 16);
        O[mt] = MFMA32(a, pf[s4], O[mt]);
      }
    }
    if (more) stage(cur ^ 1);
    __syncthreads();
  }
  float* Cb = (float*)smem;
  const float lam = ((const float*)(p.ws + OFF_LAM))[l];
  const float lam_init = 0.8f - 0.6f * expf(-0.3f * (float)l);
  const float ltot = ls + __shfl_xor(ls, 32);
  if (m == 1) {
    const float sc = lam / ltot;
#pragma unroll
    for (int mt = 0; mt < 4; ++mt)
#pragma unroll
      for (int i = 0; i < 16; ++i) Cb[(qt * 64 + mt * 16 + i) * 64 + lane] = O[mt][i] * sc;
  }
  __syncthreads();
  if (m == 0) {
    const float i0 = 1.f / ltot;
    float ss = 0.f;
#pragma unroll
    for (int mt = 0; mt < 4; ++mt)
#pragma unroll
      for (int i = 0; i < 16; ++i) {
        const float o = O[mt][i] * i0 - Cb[(qt * 64 + mt * 16 + i) * 64 + lane];
        O[mt][i] = o;
        ss += o * o;
      }
    ss += __shfl_xor(ss, 32);
    const float rs = rsqrtf(ss * (1.f / 128.f) + 1e-6f) * (1.f - lam_init);
    const u16* zseg = Pseg(p, 10);
    const float* sg = p.subln_g + l * 128;
#pragma unroll
    for (int mt = 0; mt < 4; ++mt)
#pragma unroll
      for (int g = 0; g < 4; g += 2) {
        const int dvb = mt * 32 + 8 * g;
        const float4 ga = *(const float4*)(sg + dvb + 4 * hh), gb = *(const float4*)(sg + dvb + 8 + 4 * hh);
        uint2 za, zb;
        load_pair16(zseg + (size_t)tok * 512 + h * 128 + dvb, hh, za, zb);
        const float o0 = O[mt][4 * g + 0] * rs * ga.x * bf2f(za.x & 0xffffu);
        const float o1 = O[mt][4 * g + 1] * rs * ga.y * bf2f(za.x >> 16);
        const float o2 = O[mt][4 * g + 2] * rs * ga.z * bf2f(za.y & 0xffffu);
        const float o3 = O[mt][4 * g + 3] * rs * ga.w * bf2f(za.y >> 16);
        const float o4 = O[mt][4 * g + 4] * rs * gb.x * bf2f(zb.x & 0xffffu);
        const float o5 = O[mt][4 * g + 5] * rs * gb.y * bf2f(zb.x >> 16);
        const float o6 = O[mt][4 * g + 6] * rs * gb.z * bf2f(zb.y & 0xffffu);
        const float o7 = O[mt][4 * g + 7] * rs * gb.w * bf2f(zb.y >> 16);
        store_pair16(qseg + (size_t)tok * 512 + h * 128 + dvb, make_uint2(pk2(o0, o1), pk2(o2, o3)), make_uint2(pk2(o4, o5), pk2(o6, o7)), hh);
      }
  }
  __syncthreads();
}

constexpr int NA_LD = 72;
DI void na_block(const Params& p, int l, bool sample, int b, int h, int item, u16* smem) {
  const int tid = threadIdx.x, lane = tid & 63, wid = tid >> 6, cl = lane & 31, hh = lane >> 5;
  const int row = sample ? 2 * item + (wid >> 1) : 0;
  const int c0 = sample ? (wid & 1) * 32 : 0;
  const int tok = sample ? 4096 + b * 4096 + 64 * row + c0 + cl : b * 256 + item * 128 + wid * 32 + cl;
  u16* qseg = Pseg(p, 0);
  bf16x8 qf[4];
  {
    const u16* qp = qseg + (size_t)tok * 512 + h * 64 + hh * 8;
#pragma unroll
    for (int s = 0; s < 4; ++s) qf[s] = *(const bf16x8*)(qp + s * 16);
  }
  u16* Ks = smem;
  u16* Vs = smem + 2 * 64 * NA_LD;
  float* bt = (float*)(smem + 4 * 64 * NA_LD);
  if (sample) {
    const float* rp = p.na_rpb + (size_t)(l * 8 + h) * 465;
    for (int i = tid; i < 465; i += 256) bt[i] = rp[i] * LOG2E;
  }
  f32x16 O[2];
  zero16(O[0]);
  zero16(O[1]);
  float mr = -INFINITY, ls = 0.f;
  const u16 *kc, *vc;
  int kldc;
  if (sample) {
    kc = (const u16*)(p.ws + OFF_CNK) + (size_t)(((b * 2 + l) * 8 + h) * 256) * 64;
    vc = (const u16*)(p.ws + OFF_CNVT) + (size_t)(((b * 2 + l) * 8 + h) * 64) * 256;
    kldc = 64;
  } else {
    kc = Pseg(p, 1) + (size_t)(b * 256) * 512 + h * 64;
    vc = Pseg(p, 2) + (size_t)(b * 512 + h * 64) * 256;
    kldc = 512;
  }
  const u16* kl = Pseg(p, 1) + (size_t)(4096 + b * 4096) * 512 + h * 64;
  const u16* vl = Pseg(p, 2) + (size_t)CTX_T + (size_t)(b * 512 + h * 64) * 4096;
  const int rsA = min(max(2 * item - 4, 0), 56), rsB = min(max(2 * item - 3, 0), 56);
  const int nt = sample ? 4 + (rsB + 8 - rsA) : 4;
  const int rsw = min(max(row - 4, 0), 56);
  const int qc = c0 + cl, cs = min(max(qc - 8, 0), 48);
  uint4 rk0, rk1, rv0, rv1;
  const int e0 = tid, e1 = tid + 256;
#define NA_ISSUE(T)                                                                          \
  {                                                                                          \
    const u16 *ks_, *vs_;                                                                    \
    int kld_, vld_, key0_;                                                                   \
    if ((T) < 4) { ks_ = kc; kld_ = kldc; vs_ = vc; vld_ = 256; key0_ = (T) * 64; }          \
    else { ks_ = kl; kld_ = 512; vs_ = vl; vld_ = 4096; key0_ = (rsA + (T) - 4) * 64; }      \
    rk0 = *(const uint4*)(ks_ + (size_t)(key0_ + (e0 >> 3)) * kld_ + (e0 & 7) * 8);          \
    rk1 = *(const uint4*)(ks_ + (size_t)(key0_ + (e1 >> 3)) * kld_ + (e1 & 7) * 8);          \
    rv0 = *(const uint4*)(vs_ + (size_t)(e0 >> 3) * vld_ + key0_ + (e0 & 7) * 8);            \
    rv1 = *(const uint4*)(vs_ + (size_t)(e1 >> 3) * vld_ + key0_ + (e1 & 7) * 8);            \
  }
#define NA_STAGE1(E, RK, RV, BUF)                                                            \
  {                                                                                          \
    *(uint4*)(Ks + (BUF) * 64 * NA_LD + ((E) >> 3) * NA_LD + ((E) & 7) * 8) = RK;            \
    *(uint4*)(Vs + (BUF) * 64 * NA_LD + ((E) >> 3) * NA_LD + ((E) & 7) * 8) = RV;            \
  }
#define NA_STAGE(BUF) { NA_STAGE1(e0, rk0, rv0, BUF) NA_STAGE1(e1, rk1, rv1, BUF) }
  NA_ISSUE(0)
  NA_STAGE(0)
  __syncthreads();
  for (int t = 0; t < nt; ++t) {
    const int cur = t & 1;
    const bool more = t + 1 < nt;
    if (more) NA_ISSUE(t + 1)
    const int kr = rsA + t - 4;
    const bool local = t >= 4;
    const bool active = !local || (kr >= rsw && kr < rsw + 8);
    if (active) {
      const u16* Kc = Ks + cur * 64 * NA_LD + cl * NA_LD + hh * 8;
      const u16* Vc = Vs + cur * 64 * NA_LD + cl * NA_LD + 8 * hh;
      f32x16 st0, st1;
      zero16(st0);
      zero16(st1);
#pragma unroll
      for (int s = 0; s < 4; ++s) {
        const bf16x8 a0 = *(const bf16x8*)(Kc + s * 16);
        const bf16x8 a1 = *(const bf16x8*)(Kc + 32 * NA_LD + s * 16);
        st0 = MFMA32(a0, qf[s], st0);
        st1 = MFMA32(a1, qf[s], st1);
      }
      if (local) {
        const float* br = bt + (kr - row + 7) * 31;
#pragma unroll
        for (int i = 0; i < 16; ++i) {
          const int k0 = crow(i, hh), k1 = 32 + k0;
          const bool ok0 = (k0 >= cs) && (k0 < cs + 16), ok1 = (k1 >= cs) && (k1 < cs + 16);
          const int i0 = min(max(k0 - qc + 15, 0), 30), i1 = min(max(k1 - qc + 15, 0), 30);
          st0[i] = ok0 ? st0[i] + br[i0] : -INFINITY;
          st1[i] = ok1 ? st1[i] + br[i1] : -INFINITY;
        }
      }
      float mx = fmaxf(st0[0], st1[0]);
#pragma unroll
      for (int i = 1; i < 16; ++i) mx = fmaxf(mx, fmaxf(st0[i], st1[i]));
      mx = fmaxf(mx, __shfl_xor(mx, 32));
      if (__any(mx > mr + 8.f)) {
        const float mnew = fmaxf(mr, mx);
        const float alpha = ex2(mr - mnew);
        ls *= alpha;
#pragma unroll
        for (int i = 0; i < 16; ++i) {
          O[0][i] *= alpha;
          O[1][i] *= alpha;
        }
        mr = mnew;
      }
      float sum = 0.f;
#pragma unroll
      for (int i = 0; i < 16; ++i) {
        st0[i] = ex2(st0[i] - mr);
        st1[i] = ex2(st1[i] - mr);
        sum += st0[i] + st1[i];
      }
      ls += sum;
      bf16x8 pf[4];
      pf[0] = pack8(st0, 0);
      pf[1] = pack8(st0, 1);
      pf[2] = pack8(st1, 0);
      pf[3] = pack8(st1, 1);
#pragma unroll
      for (int mt = 0; mt < 2; ++mt)
#pragma unroll
        for (int s4 = 0; s4 < 4; ++s4) {
          const bf16x8 a = *(const bf16x8*)(Vc + mt * 32 * NA_LD + s4 * 16);
          O[mt] = MFMA32(a, pf[s4], O[mt]);
        }
    }
    if (more) NA_STAGE(cur ^ 1)
    __syncthreads();
  }
#undef NA_ISSUE
#undef NA_STAGE1
#undef NA_STAGE
  const float linv = 1.f / (ls + __shfl_xor(ls, 32));
  const u16* zseg = Pseg(p, 3);
  uint2 zz[2][4];
#pragma unroll
  for (int mt = 0; mt < 2; ++mt)
#pragma unroll
    for (int g = 0; g < 4; g += 2) load_pair16(zseg + (size_t)tok * 512 + h * 64 + mt * 32 + 8 * g, hh, zz[mt][g], zz[mt][g + 1]);
#pragma unroll
  for (int mt = 0; mt < 2; ++mt)
#pragma unroll
    for (int g = 0; g < 4; g += 2) {
      const int dv = mt * 32 + 8 * g;
      const float o0 = O[mt][4 * g + 0] * linv * bf2f(zz[mt][g].x & 0xffffu);
      const float o1 = O[mt][4 * g + 1] * linv * bf2f(zz[mt][g].x >> 16);
      const float o2 = O[mt][4 * g + 2] * linv * bf2f(zz[mt][g].y & 0xffffu);
      const float o3 = O[mt][4 * g + 3] * linv * bf2f(zz[mt][g].y >> 16);
      const float o4 = O[mt][4 * g + 4] * linv * bf2f(zz[mt][g + 1].x & 0xffffu);
      const float o5 = O[mt][4 * g + 5] * linv * bf2f(zz[mt][g + 1].x >> 16);
      const float o6 = O[mt][4 * g + 6] * linv * bf2f(zz[mt][g + 1].y & 0xffffu);
      const float o7 = O[mt][4 * g + 7] * linv * bf2f(zz[mt][g + 1].y >> 16);
      store_pair16(qseg + (size_t)tok * 512 + h * 64 + dv, make_uint2(pk2(o0, o1), pk2(o2, o3)), make_uint2(pk2(o4, o5), pk2(o6, o7)), hh);
    }
}

template <int NT>
DI void frag_gemm_t(const u16* a0, const u16* a1, const u16* bp  , int b_nt_stride, int halfsteps, f32x16 (&acc)[NT]) {
  for (int half = 0; half < 2; ++half) {
    const u16* ap = half ? a1 : a0;
    const u16* bq = bp + half * halfsteps * 16;
    for (int s = 0; s < halfsteps; ++s) {
      const bf16x8 av = *(const bf16x8*)(ap + s * 16);
#pragma unroll
      for (int nt = 0; nt < NT; ++nt) {
        const bf16x8 bv = *(const bf16x8*)(bq + (size_t)nt * b_nt_stride + s * 16);
        acc[nt] = MFMA32(av, bv, acc[nt]);
      }
    }
  }
}

DI void fnet_stage1_item(const Params& p, int b, int ct) {
  const int lane = threadIdx.x & 63, cl = lane & 31, hh = lane >> 5;
  const int ch = ct >> 1, qh = ct & 1;
  const u16* D1 = (const u16*)(p.ws + OFF_D1);
  const size_t zoff = (size_t)CTX_T + ((size_t)(b * 512 + ch) * 64 + qh * 32 + cl) * 64 + hh * 8;
  f32x16 acc[4];
#pragma unroll
  for (int nt = 0; nt < 4; ++nt) zero16(acc[nt]);
  frag_gemm_t<4>(Pseg(p, 4) + zoff, Pseg(p, 5) + zoff, D1 + (size_t)cl * 128 + hh * 8, 32 * 128, 4, acc);
  const float2* TW = (const float2*)(p.ws + OFF_TW);
  u16* AT = (u16*)(p.ws + OFF_AT);
#pragma unroll
  for (int j = 0; j < 2; ++j) {
    const int k1 = 32 * j + cl;
    u16* dre = AT + ((size_t)((b * 2 + 0) * 512 + ch)) * 4096 + k1 * 64 + qh * 32;
    u16* dim = AT + ((size_t)((b * 2 + 1) * 512 + ch)) * 4096 + k1 * 64 + qh * 32;
#pragma unroll
    for (int g = 0; g < 4; g += 2) {
      float re2[8], im2[8];
#pragma unroll
      for (int e = 0; e < 8; ++e) {
        const int i = 4 * g + e;
        const float2 tw = TW[(qh * 32 + crow(i, hh)) * 64 + k1];
        const float re = acc[j][i], im = acc[j + 2][i];
        re2[e] = re * tw.x + im * tw.y;
        im2[e] = im * tw.x - re * tw.y;
      }
      store_pair16(dre + 8 * g, make_uint2(pk2(re2[0], re2[1]), pk2(re2[2], re2[3])), make_uint2(pk2(re2[4], re2[5]), pk2(re2[6], re2[7])), hh);
      store_pair16(dim + 8 * g, make_uint2(pk2(im2[0], im2[1]), pk2(im2[2], im2[3])), make_uint2(pk2(im2[4], im2[5]), pk2(im2[6], im2[7])), hh);
    }
  }
}

DI void fnet_ctx_item(const Params& p, int b, int cht, int rh) {
  const int lane = threadIdx.x & 63, cl = lane & 31, hh = lane >> 5;
  const u16* D256 = (const u16*)(p.ws + OFF_D256);
  const size_t zoff = (size_t)(b * 512 + cht * 32 + cl) * 256 + hh * 8;
  f32x16 acc[4];
#pragma unroll
  for (int nt = 0; nt < 4; ++nt) zero16(acc[nt]);
  frag_gemm_t<4>(Pseg(p, 4) + zoff, Pseg(p, 5) + zoff, D256 + (size_t)(rh * 128 + cl) * 512 + hh * 8, 32 * 512, 16, acc);
  u16* F = (u16*)(p.ws + OFF_F);
  const float sc = 0.00552427172801990f;
#pragma unroll
  for (int nt = 0; nt < 4; ++nt) {
    const int k = rh * 128 + nt * 32 + cl;
    u16* dst = F + (size_t)(b * 256 + k) * 512 + cht * 32;
#pragma unroll
    for (int g = 0; g < 4; g += 2)
      store_pair16(dst + 8 * g, make_uint2(pk2(acc[nt][4 * g] * sc, acc[nt][4 * g + 1] * sc), pk2(acc[nt][4 * g + 2] * sc, acc[nt][4 * g + 3] * sc)),
                   make_uint2(pk2(acc[nt][4 * g + 4] * sc, acc[nt][4 * g + 5] * sc), pk2(acc[nt][4 * g + 6] * sc, acc[nt][4 * g + 7] * sc)), hh);
  }
}

DI void fnet_stage2_item(const Params& p, int b, int k1, int cht) {
  const int lane = threadIdx.x & 63, cl = lane & 31, hh = lane >> 5;
  const int ch = cht * 32 + cl;
  const u16* D2 = (const u16*)(p.ws + OFF_D2);
  const u16* AT = (const u16*)(p.ws + OFF_AT);
  f32x16 acc[2];
  zero16(acc[0]);
  zero16(acc[1]);
  frag_gemm_t<2>(AT + ((size_t)((b * 2 + 0) * 512 + ch)) * 4096 + k1 * 64 + hh * 8, AT + ((size_t)((b * 2 + 1) * 512 + ch)) * 4096 + k1 * 64 + hh * 8,
                 D2 + (size_t)cl * 128 + hh * 8, 32 * 128, 4, acc);
  u16* F = (u16*)(p.ws + OFF_F);
  const float sc = 0.00138106793200498f;
#pragma unroll
  for (int nt = 0; nt < 2; ++nt) {
    const int k2 = nt * 32 + cl;
    u16* dst = F + (size_t)(4096 + b * 4096 + k1 + 64 * k2) * 512 + cht * 32;
#pragma unroll
    for (int g = 0; g < 4; g += 2)
      store_pair16(dst + 8 * g, make_uint2(pk2(acc[nt][4 * g] * sc, acc[nt][4 * g + 1] * sc), pk2(acc[nt][4 * g + 2] * sc, acc[nt][4 * g + 3] * sc)),
                   make_uint2(pk2(acc[nt][4 * g + 4] * sc, acc[nt][4 * g + 5] * sc), pk2(acc[nt][4 * g + 6] * sc, acc[nt][4 * g + 7] * sc)), hh);
  }
}

DI void phase_mixA(const Params& p, int l, u16* smem) {
  const int gw = blockIdx.x * 4 + (threadIdx.x >> 6), nw = gridDim.x * 4;
  for (int it = blockIdx.x; it < 768; it += gridDim.x) {
    const bool smp = it < 512;
    const int j = smp ? it : it - 512;
    const int b = smp ? ((j & 7) >> 2) : (j >> 4), h = smp ? (j & 3) : ((j >> 2) & 3), q64 = smp ? (j >> 3) : (j & 3);
    diff_block(p, l, smp, b, h, q64, smem);
  }
  for (int it = gridDim.x - 1 - blockIdx.x; it < 768; it += gridDim.x) {
    const bool smp = it < 512;
    const int j = smp ? it : it - 512;
    const int bh = smp ? ((j & 7) * 2 + (j >> 8)) : 0;
    const int b = smp ? (bh >> 3) : (j >> 4), h = smp ? (bh & 7) : ((j >> 1) & 7), qi = smp ? ((j >> 3) & 31) : (j & 1);
    na_block(p, l, smp, b, h, qi, smem);
  }
  for (int it = nw - 1 - gw; it < 2560; it += nw) {
    if (it < 2048) fnet_stage1_item(p, it >> 10, it & 1023);
    else { const int j = it - 2048; fnet_ctx_item(p, j >> 5, (j >> 1) & 15, j & 1); }
  }
}

DI void phase_mixB(const Params& p) {
  const int gw = blockIdx.x * 4 + (threadIdx.x >> 6), nw = gridDim.x * 4;
  for (int it = gw; it < 2048; it += nw) fnet_stage2_item(p, it >> 10, (it >> 4) & 63, it & 15);
}

DI void phase_fnetw(const Params& p, int l, u16* smem) {
  const int tid = threadIdx.x, lane = tid & 63, wid = tid >> 6, wr = wid >> 1, wc = wid & 1, cl = lane & 31, hh = lane >> 5;
  const u16* wf = (const u16*)(p.ws + OFF_WF) + (size_t)l * 512 * 512;
  const u16* F = (const u16*)(p.ws + OFF_F);
  u16* zs = Pseg(p, 6);
  int ft, tt;
  for (int it = 0; xcd_map(it, 4, 96, 1, ft, tt); ++it) {
    const int f0 = ft * 128, t0 = tt * 128;
    f32x16 acc[2][2];
#pragma unroll
    for (int a = 0; a < 2; ++a)
#pragma unroll
      for (int b = 0; b < 2; ++b) zero16(acc[a][b]);
    gemm_core<2>([&](int r) { return wf + (size_t)(f0 + r) * 512; }, [&](int c) { return F + (size_t)(t0 + c) * 512; }, 512, acc, smem);
#pragma unroll
    for (int ni = 0; ni < 2; ++ni) {
      const int tok = t0 + wc * 64 + ni * 32 + cl;
      uint2 zz[2][4];
#pragma unroll
      for (int mi = 0; mi < 2; ++mi)
#pragma unroll
        for (int g = 0; g < 4; g += 2) load_pair16(zs + (size_t)tok * 512 + f0 + wr * 64 + mi * 32 + 8 * g, hh, zz[mi][g], zz[mi][g + 1]);
#pragma unroll
      for (int mi = 0; mi < 2; ++mi)
#pragma unroll
        for (int g = 0; g < 4; g += 2) {
          const int f = f0 + wr * 64 + mi * 32 + 8 * g;
          const float o0 = acc[mi][ni][4 * g + 0] * bf2f(zz[mi][g].x & 0xffffu), o1 = acc[mi][ni][4 * g + 1] * bf2f(zz[mi][g].x >> 16);
          const float o2 = acc[mi][ni][4 * g + 2] * bf2f(zz[mi][g].y & 0xffffu), o3 = acc[mi][ni][4 * g + 3] * bf2f(zz[mi][g].y >> 16);
          const float o4 = acc[mi][ni][4 * g + 4] * bf2f(zz[mi][g + 1].x & 0xffffu), o5 = acc[mi][ni][4 * g + 5] * bf2f(zz[mi][g + 1].x >> 16);
          const float o6 = acc[mi][ni][4 * g + 6] * bf2f(zz[mi][g + 1].y & 0xffffu), o7 = acc[mi][ni][4 * g + 7] * bf2f(zz[mi][g + 1].y >> 16);
          store_pair16(zs + (size_t)tok * 512 + f, make_uint2(pk2(o0, o1), pk2(o2, o3)), make_uint2(pk2(o4, o5), pk2(o6, o7)), hh);
        }
    }
  }
}

DI int sig_seg(int b, int half) { return b == 0 ? 1 + half : (b == 1 ? 8 + half : (half ? 10 : 3)); }
DI void phase_gates(const Params& p, int l, u16* smem) {
  const int tid = threadIdx.x, lane = tid & 63, wid = tid >> 6, wr = wid >> 1, wc = wid & 1, cl = lane & 31, hh = lane >> 5;
  const u16* wt = WTl(p, l) + (size_t)5632 * 1024;
  const u16* H = (const u16*)(p.ws + OFF_H);
  int ft, tt;
  for (int it = 0; xcd_map(it, 24, 96, 4, ft, tt); ++it) {
    const int n0 = ft * 128, t0 = tt * 128;
    f32x16 acc[2][2];
#pragma unroll
    for (int a = 0; a < 2; ++a)
#pragma unroll
      for (int b = 0; b < 2; ++b) zero16(acc[a][b]);
    gemm_core<2>([&](int r) { return wt + (size_t)(n0 + r) * 1024; }, [&](int c) { return H + (size_t)(t0 + c) * 1024; }, 1024, acc, smem);
    const int bb = n0 >> 10, f = n0 & 1023;
    u16* dstseg = Pseg(p, sig_seg(bb, f >> 9));
#pragma unroll
    for (int ni = 0; ni < 2; ++ni) {
      const int tok = t0 + wc * 64 + ni * 32 + cl;
#pragma unroll
      for (int mi = 0; mi < 2; ++mi)
#pragma unroll
        for (int g = 0; g < 4; g += 2) {
          const int fc = (f & 511) + wr * 64 + mi * 32 + 8 * g;
          store_pair16(dstseg + (size_t)tok * 512 + fc,
                       make_uint2(pk2(sigmoid_f(acc[mi][ni][4 * g]), sigmoid_f(acc[mi][ni][4 * g + 1])),
                                  pk2(sigmoid_f(acc[mi][ni][4 * g + 2]), sigmoid_f(acc[mi][ni][4 * g + 3]))),
                       make_uint2(pk2(sigmoid_f(acc[mi][ni][4 * g + 4]), sigmoid_f(acc[mi][ni][4 * g + 5])),
                                  pk2(sigmoid_f(acc[mi][ni][4 * g + 6]), sigmoid_f(acc[mi][ni][4 * g + 7]))), hh);
        }
    }
  }
}

DI void phase_merge(const Params& p, int l, u16* smem) {
  const int tid = threadIdx.x, lane = tid & 63, wid = tid >> 6, wr = wid >> 1, wc = wid & 1, cl = lane & 31, hh = lane >> 5;
  const u16* WB = (const u16*)(p.ws + OFF_WB) + (size_t)l * 3 * 1024 * 512;
  u16* Y = Pseg(p, 4);
  int ft, tt;
  for (int it = 0; xcd_map(it, 8, 96, 2, ft, tt); ++it) {
    const int f0 = ft * 128, t0 = tt * 128;
    f32x16 y[2][2];
#pragma unroll
    for (int a = 0; a < 2; ++a)
#pragma unroll
      for (int b = 0; b < 2; ++b) zero16(y[a][b]);
#pragma unroll 1
    for (int b = 0; b < 3; ++b) {
      f32x16 au[2][2];
#pragma unroll
      for (int a = 0; a < 2; ++a)
#pragma unroll
        for (int c = 0; c < 2; ++c) zero16(au[a][c]);
      const u16* U = Pseg(p, b == 0 ? 0 : (b == 1 ? 6 : 7));
      const u16* wb = WB + (size_t)b * 1024 * 512;
      gemm_core<2, false>([&](int r) { return wb + (size_t)(f0 + r) * 512; }, [&](int c) { return U + (size_t)(t0 + c) * 512; }, 512, au, smem);
      const u16* sg = Pseg(p, sig_seg(b, f0 >> 9));
#pragma unroll
      for (int ni = 0; ni < 2; ++ni) {
        const int tok = t0 + wc * 64 + ni * 32 + cl;
#pragma unroll
        for (int mi = 0; mi < 2; ++mi)
#pragma unroll
          for (int g = 0; g < 4; g += 2) {
            const int fc = (f0 & 511) + wr * 64 + mi * 32 + 8 * g;
            uint2 za, zb;
            load_pair16(sg + (size_t)tok * 512 + fc, hh, za, zb);
            y[mi][ni][4 * g + 0] += au[mi][ni][4 * g + 0] * bf2f(za.x & 0xffffu);
            y[mi][ni][4 * g + 1] += au[mi][ni][4 * g + 1] * bf2f(za.x >> 16);
            y[mi][ni][4 * g + 2] += au[mi][ni][4 * g + 2] * bf2f(za.y & 0xffffu);
            y[mi][ni][4 * g + 3] += au[mi][ni][4 * g + 3] * bf2f(za.y >> 16);
            y[mi][ni][4 * g + 4] += au[mi][ni][4 * g + 4] * bf2f(zb.x & 0xffffu);
            y[mi][ni][4 * g + 5] += au[mi][ni][4 * g + 5] * bf2f(zb.x >> 16);
            y[mi][ni][4 * g + 6] += au[mi][ni][4 * g + 6] * bf2f(zb.y & 0xffffu);
            y[mi][ni][4 * g + 7] += au[mi][ni][4 * g + 7] * bf2f(zb.y >> 16);
          }
      }
    }
#pragma unroll
    for (int ni = 0; ni < 2; ++ni) {
      const int tok = t0 + wc * 64 + ni * 32 + cl;
#pragma unroll
      for (int mi = 0; mi < 2; ++mi)
#pragma unroll
        for (int g = 0; g < 4; g += 2) {
          const int f = f0 + wr * 64 + mi * 32 + 8 * g;
          store_pair16(Y + (size_t)tok * 1024 + f, make_uint2(pk2(y[mi][ni][4 * g], y[mi][ni][4 * g + 1]), pk2(y[mi][ni][4 * g + 2], y[mi][ni][4 * g + 3])),
                       make_uint2(pk2(y[mi][ni][4 * g + 4], y[mi][ni][4 * g + 5]), pk2(y[mi][ni][4 * g + 6], y[mi][ni][4 * g + 7])), hh);
        }
    }
  }
}

DI void phase_wout(const Params& p, int l, u16* smem) {
  const int tid = threadIdx.x, lane = tid & 63, wid = tid >> 6, wr = wid >> 1, wc = wid & 1, cl = lane & 31, hh = lane >> 5;
  const u16* wo = (const u16*)(p.ws + OFF_WO) + (size_t)l * 1024 * 1024;
  const u16* Y = Pseg(p, 4);
  const float* MOD = (const float*)(p.ws + OFF_MOD);
  int ft, tt;
  for (int it = 0; xcd_map(it, 8, 96, 2, ft, tt); ++it) {
    const int f0 = ft * 128, t0 = tt * 128;
    f32x16 acc[2][2];
#pragma unroll
    for (int a = 0; a < 2; ++a)
#pragma unroll
      for (int b = 0; b < 2; ++b) zero16(acc[a][b]);
    gemm_core<2>([&](int r) { return wo + (size_t)(f0 + r) * 1024; }, [&](int c) { return Y + (size_t)(t0 + c) * 1024; }, 1024, acc, smem);
#pragma unroll
    for (int ni = 0; ni < 2; ++ni) {
      const int tok = t0 + wc * 64 + ni * 32 + cl;
      const float* xr = xin(p, l, tok);
      const float* gate = MOD + (l * 3 + vec_of(tok)) * 3072 + 2048;
      float* orow = p.out + (size_t)tok * 1024;
      float4 xv[2][4], gv[2][4];
#pragma unroll
      for (int mi = 0; mi < 2; ++mi)
#pragma unroll
        for (int g = 0; g < 4; ++g) {
          const int f = f0 + wr * 64 + mi * 32 + 4 * hh + 8 * g;
          xv[mi][g] = *(const float4*)(xr + f);
          gv[mi][g] = *(const float4*)(gate + f);
        }
#pragma unroll
      for (int mi = 0; mi < 2; ++mi)
#pragma unroll
        for (int g = 0; g < 4; ++g) {
          const int f = f0 + wr * 64 + mi * 32 + 4 * hh + 8 * g;
          float4 o;
          o.x = xv[mi][g].x + gv[mi][g].x * acc[mi][ni][4 * g + 0];
          o.y = xv[mi][g].y + gv[mi][g].y * acc[mi][ni][4 * g + 1];
          o.z = xv[mi][g].z + gv[mi][g].z * acc[mi][ni][4 * g + 2];
          o.w = xv[mi][g].w + gv[mi][g].w * acc[mi][ni][4 * g + 3];
          *(float4*)(orow + f) = o;
        }
    }
  }
}

DI void phase_final(const Params& p) {
  const int lane = threadIdx.x & 63, wid = threadIdx.x >> 6;
  for (int row = (blockIdx.x * 4 + wid) * 2; row < 12288; row += gridDim.x * 8) {
    float* x0 = p.out + (size_t)row * 1024;
    float* x1 = x0 + 1024;
    float4 xa[4], xb[4], g[4];
#pragma unroll
    for (int j = 0; j < 4; ++j) {
      xa[j] = *(const float4*)(x0 + j * 256 + lane * 4);
      xb[j] = *(const float4*)(x1 + j * 256 + lane * 4);
      g[j] = *(const float4*)(p.final_g + j * 256 + lane * 4);
    }
    float sa = 0.f, sb = 0.f;
#pragma unroll
    for (int j = 0; j < 4; ++j) {
      sa += xa[j].x * xa[j].x + xa[j].y * xa[j].y + xa[j].z * xa[j].z + xa[j].w * xa[j].w;
      sb += xb[j].x * xb[j].x + xb[j].y * xb[j].y + xb[j].z * xb[j].z + xb[j].w * xb[j].w;
    }
#pragma unroll
    for (int o = 32; o; o >>= 1) {
      sa += __shfl_xor(sa, o);
      sb += __shfl_xor(sb, o);
    }
    const float ra = rsqrtf(sa * (1.f / 1024.f) + 1e-6f), rb = rsqrtf(sb * (1.f / 1024.f) + 1e-6f);
#pragma unroll
    for (int j = 0; j < 4; ++j) {
      const int col = j * 256 + lane * 4;
      *(float4*)(x0 + col) = make_float4(xa[j].x * ra * g[j].x, xa[j].y * ra * g[j].y, xa[j].z * ra * g[j].z, xa[j].w * ra * g[j].w);
      *(float4*)(x1 + col) = make_float4(xb[j].x * rb * g[j].x, xb[j].y * rb * g[j].y, xb[j].z * rb * g[j].z, xb[j].w * rb * g[j].w);
    }
  }
}

#define XB_TMO      128
#define XB_XCNT(j)  (256  + 64 * (j))
#define XB_XSUB(j)  (1280 + 64 * (j))
#define XB_XGEN(j)  (2304 + 64 * (j))
#define XB_TOP      3328
#define XB_TOPGEN   3392
#define XB_SPIN_CAP (1u << 18)
#define LAS __attribute__((address_space(3)))
DI unsigned xb_ld(unsigned* p) { return __hip_atomic_load(p, __ATOMIC_RELAXED, __HIP_MEMORY_SCOPE_AGENT); }
DI unsigned xb_add(unsigned* p, unsigned v) { return __hip_atomic_fetch_add(p, v, __ATOMIC_RELAXED, __HIP_MEMORY_SCOPE_AGENT); }
DI unsigned xb_xcc_id() { return (unsigned)__builtin_amdgcn_s_getreg((3 << 11) | 20) & 0xFu; }
#define XB_SPIN(cond, bar) do { unsigned _sp = 0; while (cond) { __builtin_amdgcn_s_sleep(1); \
    if ((++_sp & 255u) == 0u) { if (xb_ld(&(bar)[XB_TMO])) break; if (_sp > XB_SPIN_CAP) { atomicAdd(&(bar)[XB_TMO], 1u); break; } } } } while (0)
struct XcdBarrier {
  unsigned* bar;
  unsigned x;
  volatile LAS unsigned* st;
};
DI XcdBarrier xcd_barrier_post(unsigned* bar, volatile LAS unsigned* st) {
  XcdBarrier b;
  b.bar = bar;
  b.x = xb_xcc_id();
  b.st = st;
  if (threadIdx.x == 0) (void)xb_add(&bar[XB_XCNT(b.x)], 1u);
  return b;
}
DI void xcd_barrier_complete(unsigned* bar, unsigned x, unsigned& nloc, unsigned& nx) {
  const unsigned G = gridDim.x * gridDim.y * gridDim.z;
  unsigned sum, cnt, mine, sp = 0u;
  for (;;) {
    sum = 0u; cnt = 0u; mine = 0u;
#pragma unroll
    for (unsigned j = 0; j < 16; ++j) {
      const unsigned c = xb_ld(&bar[XB_XCNT(j)]);
      sum += c;
      cnt += (c > 0u) ? 1u : 0u;
      mine = (j == x) ? c : mine;
    }
    if (sum == G) break;
    __builtin_amdgcn_s_sleep(1);
    if ((++sp & 255u) == 0u) {
      if (xb_ld(&bar[XB_TMO])) break;
      if (sp > XB_SPIN_CAP) { atomicAdd(&bar[XB_TMO], 1u); break; }
    }
  }
  nloc = mine > 0u ? mine : 1u;
  nx = cnt > 0u ? cnt : 1u;
}
DI void xcd_barrier(const XcdBarrier& b) {
  asm volatile("s_waitcnt vmcnt(0)" ::: "memory");
  __syncthreads();
  if (threadIdx.x == 0) {
    unsigned* bar = b.bar;
    __builtin_amdgcn_s_waitcnt(0);
    unsigned nloc = b.st[0], nx = b.st[1];
    if (nloc == 0u) {
      xcd_barrier_complete(bar, b.x, nloc, nx);
      b.st[0] = nloc;
      b.st[1] = nx;
    }
    const unsigned old = xb_add(&bar[XB_XSUB(b.x)], 1u);
    const unsigned gen = old / nloc;
    if (old + 1u == (gen + 1u) * nloc) {
      __builtin_amdgcn_fence(__ATOMIC_RELEASE, "agent");
      asm volatile("s_waitcnt vmcnt(0)" ::: "memory");
      const unsigned og = xb_add(&bar[XB_TOP], 1u);
      const unsigned tg = og / nx;
      if (og + 1u == (tg + 1u) * nx) xb_add(&bar[XB_TOPGEN], 1u);
      else XB_SPIN(xb_ld(&bar[XB_TOPGEN]) == tg, bar);
      __builtin_amdgcn_fence(__ATOMIC_ACQUIRE, "agent");
      xb_add(&bar[XB_XGEN(b.x)], 1u);
      asm volatile("s_waitcnt vmcnt(0)" ::: "memory");
    } else {
      XB_SPIN(xb_ld(&bar[XB_XGEN(b.x)]) == gen, bar);
      __builtin_amdgcn_fence(__ATOMIC_ACQUIRE, "agent");
      asm volatile("s_waitcnt vmcnt(0)" ::: "memory");
    }
  }
  __syncthreads();
}

constexpr int SMEM_BYTES = (2 * 128 * LDT + 2 * 128 * LDT) * 2;

__global__ void __launch_bounds__(256, 2) fwd_megakernel(Params p, int ph_lo, int ph_hi, int use_cg) {
  __shared__ __attribute__((aligned(16))) char smem[SMEM_BYTES];
  __shared__ uint4 xb_words;
  cg::grid_group grid = cg::this_grid();
  if (threadIdx.x == 0) xb_words = make_uint4(0u, 0u, 0u, 0u);
  __syncthreads();
  XcdBarrier xb = xcd_barrier_post((unsigned*)(p.ws + OFF_BAR), (volatile LAS unsigned*)&xb_words);
#define GRID_SYNC() do { if (use_cg) grid.sync(); else xcd_barrier(xb); } while (0)
#define RUN_PHASE(PH, CALL)                       \
  if (ph_lo <= (PH) && (PH) < ph_hi) {            \
    CALL;                                         \
    if ((PH) + 1 < ph_hi) GRID_SYNC();            \
  }
#define RUN_LAYER(L)                                                                           \
  RUN_PHASE(1 + 7 * (L) + 0, { phase_h(p, (L)); if ((L) == 0) phase_prep(p, smem, 2); })        \
  RUN_PHASE(1 + 7 * (L) + 1, phase_win(p, (L), (u16*)smem))                                    \
  RUN_PHASE(1 + 7 * (L) + 2, phase_mixA(p, (L), (u16*)smem))                                   \
  RUN_PHASE(1 + 7 * (L) + 3, { phase_mixB(p); phase_gates(p, (L), (u16*)smem); })              \
  RUN_PHASE(1 + 7 * (L) + 4, phase_fnetw(p, (L), (u16*)smem))                                  \
  RUN_PHASE(1 + 7 * (L) + 5, phase_merge(p, (L), (u16*)smem))                                  \
  RUN_PHASE(1 + 7 * (L) + 6, phase_wout(p, (L), (u16*)smem))
  RUN_PHASE(0, phase_prep(p, smem, 1))
  RUN_LAYER(0)
  RUN_LAYER(1)
  RUN_PHASE(15, phase_final(p))
}

extern "C" void kernel_launch(void* const* d_in, const int* in_sizes, int n_in, void* d_out, int out_size, void* d_ws, size_t ws_size,
                              hipStream_t stream) {
  static int grid_blocks = 0;
  if (!grid_blocks) {
    int dev = 0, cus = 0, per_cu = 0;
    hipGetDevice(&dev);
    hipDeviceGetAttribute(&cus, hipDeviceAttributeMultiprocessorCount, dev);
    hipOccupancyMaxActiveBlocksPerMultiprocessor(&per_cu, fwd_megakernel, 256, 0);
    if (per_cu > 2) per_cu = 2;
    if (per_cu < 1) per_cu = 1;
    grid_blocks = cus * per_cu;
  }
  Params p{};
  const float** pp = (const float**)&p;
  for (int i = 0; i < 22; ++i) pp[i] = (const float*)d_in[i];
  p.out = (float*)d_out;
  p.ws = (char*)d_ws;
  int lo = 0, hi = 16, use_cg = 0;
  hipMemsetAsync((char*)d_ws + OFF_BAR, 0, BAR_BYTES, stream);
  void* args[] = {&p, &lo, &hi, &use_cg};
  hipError_t e = hipLaunchCooperativeKernel((void*)fwd_megakernel, dim3(grid_blocks), dim3(256), args, 0, stream);
  if (e != hipSuccess) fprintf(stderr, "cooperative launch failed: %s (grid %d)\n", hipGetErrorString(e), grid_blocks);
}
```
